# Optimizing an MI355X kernel written in HIP

```python
import math
import jax
import jax.numpy as jnp
from jax import lax
import numpy as np

D_MODEL = 2048
BATCH = 32
SEQ = 256
DEPTH = 4
DEC_BATCH = 8
DEC_SEQ = 4096
PAST_LEN = 256

GRID_W = 64
HEAD_DIM = 128
QBLOCK = 128
ROPE_BASE = 10000.0
NEG_INF = -1e30
N_MIXERS = 3
A_HEADS = D_MODEL // HEAD_DIM
A_KV_HEADS = A_HEADS // 4
A_GROUP = A_HEADS // A_KV_HEADS
WINDOW = 128
A_SPLIT = (A_HEADS * HEAD_DIM, A_HEADS * HEAD_DIM + A_KV_HEADS * HEAD_DIM, A_HEADS * HEAD_DIM + 2 * A_KV_HEADS * HEAD_DIM)
A_IN = 2 * A_HEADS * HEAD_DIM + 2 * A_KV_HEADS * HEAD_DIM
B_HEADS = D_MODEL // (2 * HEAD_DIM)
B_IN = 4 * B_HEADS * 2 * HEAD_DIM
C_HEADS = D_MODEL // HEAD_DIM
NA_KH = 8
NA_KW = 16
C_IN = 4 * C_HEADS * HEAD_DIM
N_A = len(range(0, DEPTH, N_MIXERS))
N_B = len(range(1, DEPTH, N_MIXERS))
N_C = len(range(2, DEPTH, N_MIXERS))
SCALE = HEAD_DIM ** -0.5

kernel_name = 'hybrid_diffusion_prefix_trunk'


def rms_norm(x, g, eps=1e-6):
    xf = x.astype(jnp.float32)
    y = xf * lax.rsqrt(jnp.mean(xf * xf, axis=-1, keepdims=True) + eps)
    return (y * g.astype(jnp.float32)).astype(x.dtype)


def ada_modulation(cvec, w, b):
    m = (jax.nn.silu(cvec) @ w + b)[:, None, :]
    shift, scale, gate = jnp.split(m, 3, axis=-1)
    return shift, scale, gate


def axial_rope_tables(n_tokens):
    d4 = HEAD_DIM // 4
    t = jnp.arange(n_tokens)
    pos = jnp.stack([t // GRID_W, t % GRID_W], axis=-1).astype(jnp.float32)
    inv_freq = ROPE_BASE ** (-jnp.arange(d4, dtype=jnp.float32) / d4)
    ang = pos[:, :, None] * inv_freq
    return jnp.cos(ang), jnp.sin(ang)


def apply_rope(x, cos, sin):
    n = x.shape[1]
    d4 = x.shape[-1] // 4
    bshape = (n,) + (1,) * (x.ndim - 3) + (2, d4)
    c = cos.reshape(bshape)
    s = sin.reshape(bshape)
    xf = x.astype(jnp.float32).reshape(x.shape[:-1] + (2, 2, d4))
    x1 = xf[..., 0, :]
    x2 = xf[..., 1, :]
    out = jnp.stack([x1 * c - x2 * s, x2 * c + x1 * s], axis=-2)
    return out.reshape(x.shape).astype(x.dtype)


def dense_attention(q, k, v, sink=None):
    b, n, h, d = q.shape
    kv = k.shape[2]
    grp = h // kv
    qb = q.reshape(b, n // QBLOCK, QBLOCK, kv, grp, d).transpose(1, 0, 2, 3, 4, 5)

    def block(qi):
        s = jnp.einsum('bqkgd,blkd->bkgql', qi, k, preferred_element_type=jnp.float32) * SCALE
        if sink is not None:
            sk = jnp.broadcast_to(sink.astype(jnp.float32).reshape(kv, grp, 1, 1), s.shape[:-1] + (1,))
            p = jax.nn.softmax(jnp.concatenate([s, sk], axis=-1), axis=-1)[..., :-1]
        else:
            p = jax.nn.softmax(s, axis=-1)
        return jnp.einsum('bkgql,blkd->bqkgd', p.astype(v.dtype), v)

    o = lax.map(block, qb)
    return o.transpose(1, 0, 2, 3, 4, 5).reshape(b, n, h * d)


def a_project(h, w_in, qg, kg):
    b, n, _ = h.shape
    q, k, v, g = jnp.split(h @ w_in, A_SPLIT, axis=-1)
    q = rms_norm(q.reshape(b, n, A_HEADS, HEAD_DIM), qg)
    k = rms_norm(k.reshape(b, n, A_KV_HEADS, HEAD_DIM), kg)
    v = v.reshape(b, n, A_KV_HEADS, HEAD_DIM)
    return q, k, v, g


def window_attn_ctx(h, w_in, qg, kg, sink):
    q, k, v, g = a_project(h, w_in, qg, kg)
    o = dense_attention(q, k, v, sink)
    return o * jax.nn.silu(g), k, v


def window_attn_lat(h, k_ctx, v_ctx, w_in, qg, kg, sink, cos, sin):
    b, n, _ = h.shape
    nb = n // QBLOCK
    n_ctx = k_ctx.shape[1]
    span = 3 * QBLOCK
    q, k, v, g = a_project(h, w_in, qg, kg)
    q = apply_rope(q, cos, sin)
    k = apply_rope(k, cos, sin)
    pad = ((0, 0), (QBLOCK, QBLOCK), (0, 0), (0, 0))
    kp = jnp.pad(k, pad).reshape(b, nb + 2, QBLOCK, A_KV_HEADS, HEAD_DIM)
    vp = jnp.pad(v, pad).reshape(b, nb + 2, QBLOCK, A_KV_HEADS, HEAD_DIM)
    kband = jnp.concatenate([kp[:, :-2], kp[:, 1:-1], kp[:, 2:]], axis=2).transpose(1, 0, 2, 3, 4)
    vband = jnp.concatenate([vp[:, :-2], vp[:, 1:-1], vp[:, 2:]], axis=2).transpose(1, 0, 2, 3, 4)
    qb = q.reshape(b, nb, QBLOCK, A_KV_HEADS, A_GROUP, HEAD_DIM).transpose(1, 0, 2, 3, 4, 5)
    rel = jnp.arange(span)[None, :] - QBLOCK - jnp.arange(QBLOCK)[:, None]
    in_window = jnp.abs(rel) <= WINDOW
    sk = jnp.broadcast_to(sink.astype(jnp.float32).reshape(A_KV_HEADS, A_GROUP, 1, 1),
                          (b, A_KV_HEADS, A_GROUP, QBLOCK, 1))

    def block(args):
        qi, ki, vi, blk = args
        kpos = (blk - 1) * QBLOCK + jnp.arange(span)
        valid = in_window & ((kpos >= 0) & (kpos < n))[None, :]
        s_loc = jnp.einsum('bqkgd,bjkd->bkgqj', qi, ki, preferred_element_type=jnp.float32) * SCALE
        s_loc = jnp.where(valid, s_loc, NEG_INF)
        s_ctx = jnp.einsum('bqkgd,blkd->bkgql', qi, k_ctx, preferred_element_type=jnp.float32) * SCALE
        p = jax.nn.softmax(jnp.concatenate([s_loc, s_ctx, sk], axis=-1), axis=-1)
        p_loc = p[..., :span].astype(vi.dtype)
        p_ctx = p[..., span:span + n_ctx].astype(v_ctx.dtype)
        return (jnp.einsum('bkgqj,bjkd->bqkgd', p_loc, vi)
                + jnp.einsum('bkgql,blkd->bqkgd', p_ctx, v_ctx))

    o = lax.map(block, (qb, kband, vband, jnp.arange(nb)))
    o = o.transpose(1, 0, 2, 3, 4, 5).reshape(b, n, A_HEADS * HEAD_DIM)
    return o * jax.nn.silu(g)


def b_project(h, w_in, qg, kg):
    b, n, _ = h.shape
    q, k, v, g = jnp.split(h @ w_in, 4, axis=-1)
    q = rms_norm(q.reshape(b, n, B_HEADS, 2, HEAD_DIM), qg)
    k = rms_norm(k.reshape(b, n, B_HEADS, 2, HEAD_DIM), kg)
    v = v.reshape(b, n, B_HEADS, 2 * HEAD_DIM)
    return q, k, v, g


def diff_lambda(lam, lambda_init):
    lam = lam.astype(jnp.float32)
    return jnp.exp(jnp.sum(lam[0] * lam[1])) - jnp.exp(jnp.sum(lam[2] * lam[3])) + lambda_init


def diff_attention(q, k, v, lam_full, subln, lambda_init, g):
    b, n = q.shape[:2]
    qb = q.reshape(b, n // QBLOCK, QBLOCK, B_HEADS, 2, HEAD_DIM).transpose(1, 0, 2, 3, 4, 5)

    def block(qi):
        s = jnp.einsum('bqhmd,bkhmd->bhmqk', qi, k, preferred_element_type=jnp.float32) * SCALE
        p = jax.nn.softmax(s, axis=-1)
        a = p[:, :, 0] - lam_full * p[:, :, 1]
        return jnp.einsum('bhqk,bkhe->bqhe', a.astype(v.dtype), v)

    o = lax.map(block, qb).transpose(1, 0, 2, 3, 4).reshape(b, n, B_HEADS, 2 * HEAD_DIM)
    o = rms_norm(o, subln) * (1.0 - lambda_init)
    return o.reshape(b, n, B_HEADS * 2 * HEAD_DIM) * jax.nn.silu(g)


def diff_attn_ctx(h, w_in, qg, kg, lam, subln, lambda_init):
    q, k, v, g = b_project(h, w_in, qg, kg)
    o = diff_attention(q, k, v, diff_lambda(lam, lambda_init), subln, lambda_init, g)
    return o, k, v


def diff_attn_lat(h, k_ctx, v_ctx, w_in, qg, kg, lam, subln, lambda_init, cos, sin):
    q, k, v, g = b_project(h, w_in, qg, kg)
    q = apply_rope(q, cos, sin)
    k = apply_rope(k, cos, sin)
    k_all = jnp.concatenate([k, k_ctx.astype(k.dtype)], axis=1)
    v_all = jnp.concatenate([v, v_ctx.astype(v.dtype)], axis=1)
    return diff_attention(q, k_all, v_all, diff_lambda(lam, lambda_init), subln, lambda_init, g)


def c_project(h, w_in, qg, kg):
    b, n, _ = h.shape
    q, k, v, g = jnp.split(h @ w_in, 4, axis=-1)
    q = rms_norm(q.reshape(b, n, C_HEADS, HEAD_DIM), qg)
    k = rms_norm(k.reshape(b, n, C_HEADS, HEAD_DIM), kg)
    v = v.reshape(b, n, C_HEADS, HEAD_DIM)
    return q, k, v, g


def na_ctx(h, w_in, qg, kg):
    q, k, v, g = c_project(h, w_in, qg, kg)
    return dense_attention(q, k, v) * jax.nn.silu(g), k, v


def na_lat(h, k_ctx, v_ctx, w_in, qg, kg, rpb):
    b, n, _ = h.shape
    rows = n // GRID_W
    kh = min(NA_KH, rows)
    q, k, v, g = c_project(h, w_in, qg, kg)
    q_rows = q.reshape(b, rows, GRID_W, C_HEADS, HEAD_DIM).transpose(1, 0, 2, 3, 4)
    k_grid = k.reshape(b, rows, GRID_W, C_HEADS, HEAD_DIM)
    v_grid = v.reshape(b, rows, GRID_W, C_HEADS, HEAD_DIM)
    cols = jnp.arange(GRID_W)
    col_start = jnp.clip(cols - NA_KW // 2, 0, GRID_W - NA_KW)
    col_idx = col_start[:, None] + jnp.arange(NA_KW)
    col_bias_idx = col_idx - cols[:, None] + NA_KW - 1
    n_loc = kh * NA_KW

    def row_block(args):
        qr, r = args
        rs = jnp.clip(r - kh // 2, 0, rows - kh)
        kb = lax.dynamic_slice_in_dim(k_grid, rs, kh, axis=1)
        vb = lax.dynamic_slice_in_dim(v_grid, rs, kh, axis=1)
        kw = kb[:, :, col_idx]
        vw = vb[:, :, col_idx]
        row_bias_idx = rs + jnp.arange(kh) - r + NA_KH - 1
        bias = rpb[:, row_bias_idx[None, :, None], col_bias_idx[:, None, :]]
        s_loc = jnp.einsum('bchd,brcwhd->bhcrw', qr, kw, preferred_element_type=jnp.float32) * SCALE
        s_loc = (s_loc + bias.astype(jnp.float32)).reshape(b, C_HEADS, GRID_W, n_loc)
        s_ctx = jnp.einsum('bchd,blhd->bhcl', qr, k_ctx, preferred_element_type=jnp.float32) * SCALE
        p = jax.nn.softmax(jnp.concatenate([s_loc, s_ctx], axis=-1), axis=-1)
        p_loc = p[..., :n_loc].reshape(b, C_HEADS, GRID_W, kh, NA_KW).astype(vw.dtype)
        p_ctx = p[..., n_loc:].astype(v_ctx.dtype)
        return (jnp.einsum('bhcrw,brcwhd->bchd', p_loc, vw)
                + jnp.einsum('bhcl,blhd->bchd', p_ctx, v_ctx))

    o = lax.map(row_block, (q_rows, jnp.arange(rows)))
    o = o.transpose(1, 0, 2, 3, 4).reshape(b, n, C_HEADS * HEAD_DIM)
    return o * jax.nn.silu(g)


def setup_inputs(seed: int = 0) -> dict:
    key = jax.random.key(seed)
    ks = jax.random.split(key, 23)
    d = D_MODEL

    def nrm(i, shape, std):
        return std * jax.random.normal(ks[i], shape, jnp.float32)

    w_std = d ** -0.5
    return {
        'x_prompt': nrm(0, (BATCH, SEQ, d), 1.0),
        'x_sample': nrm(1, (DEC_BATCH, DEC_SEQ, d), 1.0),
        'cache_a_k': nrm(2, (DEC_BATCH, N_A, PAST_LEN, A_KV_HEADS, HEAD_DIM), 1.0),
        'cache_a_v': nrm(3, (DEC_BATCH, N_A, PAST_LEN, A_KV_HEADS, HEAD_DIM), 1.0),
        'cache_b_k': nrm(4, (DEC_BATCH, N_B, PAST_LEN, B_HEADS, 2, HEAD_DIM), 1.0),
        'cache_b_v': nrm(5, (DEC_BATCH, N_B, PAST_LEN, B_HEADS, 2 * HEAD_DIM), 1.0),
        'cache_c_k': nrm(6, (DEC_BATCH, N_C, PAST_LEN, C_HEADS, HEAD_DIM), 1.0),
        'cache_c_v': nrm(7, (DEC_BATCH, N_C, PAST_LEN, C_HEADS, HEAD_DIM), 1.0),
        'c': nrm(8, (DEC_BATCH, d), 1.0),
        'c_ctx': nrm(9, (d,), 1.0),
        'ln_g': 1.0 + nrm(10, (DEPTH, d), 0.02),
        'ada_w': nrm(11, (DEPTH, d, 3 * d), 0.5 * w_std),
        'ada_b': nrm(12, (DEPTH, 3 * d), 0.02),
        'w_out': nrm(13, (DEPTH, d, d), w_std),
        'qn_g': 1.0 + nrm(14, (DEPTH, HEAD_DIM), 0.02),
        'kn_g': 1.0 + nrm(15, (DEPTH, HEAD_DIM), 0.02),
        'w_in_a': nrm(16, (N_A, d, A_IN), w_std),
        'sink_a': nrm(17, (N_A, A_HEADS), 0.5),
        'w_in_b': nrm(18, (N_B, d, B_IN), w_std),
        'lam_b': nrm(19, (N_B, 4, HEAD_DIM), 0.1),
        'subln_b': 1.0 + nrm(20, (N_B, 2 * HEAD_DIM), 0.02),
        'w_in_c': nrm(21, (N_C, d, C_IN), w_std),
        'rpb_c': nrm(22, (N_C, C_HEADS, 2 * NA_KH - 1, 2 * NA_KW - 1), 0.5),
    }


def reference(x_prompt, x_sample, cache_a_k, cache_a_v, cache_b_k, cache_b_v, cache_c_k, cache_c_v,
              c, c_ctx, ln_g, ada_w, ada_b, w_out, qn_g, kn_g, w_in_a, sink_a, w_in_b, lam_b,
              subln_b, w_in_c, rpb_c):
    cos, sin = axial_rope_tables(x_sample.shape[1])
    xp = x_prompt
    xs = x_sample
    a_k, a_v, b_k, b_v, c_k, c_v = [], [], [], [], [], []
    for l in range(DEPTH):
        kind = l % N_MIXERS
        j = l // N_MIXERS
        sh_p, sc_p, gt_p = ada_modulation(c_ctx[None, :], ada_w[l], ada_b[l])
        sh_s, sc_s, gt_s = ada_modulation(c, ada_w[l], ada_b[l])
        hp = rms_norm(xp, ln_g[l]) * (1.0 + sc_p) + sh_p
        hs = rms_norm(xs, ln_g[l]) * (1.0 + sc_s) + sh_s
        if kind == 0:
            op, kp, vp = window_attn_ctx(hp, w_in_a[j], qn_g[l], kn_g[l], sink_a[j])
            os_ = window_attn_lat(hs, cache_a_k[:, j], cache_a_v[:, j], w_in_a[j], qn_g[l], kn_g[l],
                                  sink_a[j], cos, sin)
            a_k.append(kp)
            a_v.append(vp)
        elif kind == 1:
            lambda_init = 0.8 - 0.6 * math.exp(-0.3 * l)
            op, kp, vp = diff_attn_ctx(hp, w_in_b[j], qn_g[l], kn_g[l], lam_b[j], subln_b[j], lambda_init)
            os_ = diff_attn_lat(hs, cache_b_k[:, j], cache_b_v[:, j], w_in_b[j], qn_g[l], kn_g[l],
                                lam_b[j], subln_b[j], lambda_init, cos, sin)
            b_k.append(kp)
            b_v.append(vp)
        else:
            op, kp, vp = na_ctx(hp, w_in_c[j], qn_g[l], kn_g[l])
            os_ = na_lat(hs, cache_c_k[:, j], cache_c_v[:, j], w_in_c[j], qn_g[l], kn_g[l], rpb_c[j])
            c_k.append(kp)
            c_v.append(vp)
        xp = xp + gt_p * (op @ w_out[l])
        xs = xs + gt_s * (os_ @ w_out[l])
    return (xp, xs, jnp.stack(a_k, axis=1), jnp.stack(a_v, axis=1), jnp.stack(b_k, axis=1),
            jnp.stack(b_v, axis=1), jnp.stack(c_k, axis=1), jnp.stack(c_v, axis=1))
```

```cpp
#include <hip/hip_runtime.h>
#include <hip/hip_cooperative_groups.h>
#include <cstdio>
#include <cstdint>
namespace cg = cooperative_groups;

#define DI __device__ __forceinline__
#define LAS __attribute__((address_space(3)))
typedef unsigned short bf16_t;
typedef short bf16x8 __attribute__((ext_vector_type(8)));
typedef short s16x4 __attribute__((ext_vector_type(4)));
typedef float f32x4 __attribute__((ext_vector_type(4)));
typedef float f32x16 __attribute__((ext_vector_type(16)));
typedef unsigned u32x4 __attribute__((ext_vector_type(4)));
typedef unsigned u32x2 __attribute__((ext_vector_type(2)));

constexpr int DM = 2048, M_CTX = 8192, M_LAT = 32768, MT = 40960;
constexpr float SCALE = 0.088388347648318440f;
constexpr float LOG2E = 1.4426950408889634f;
constexpr float LINIT = 0.35550906759f;
constexpr int NTHREADS = 512;
constexpr int XB_ST_OFF = 149504;
constexpr int LDS_BYTES = 149504 + 16;

constexpr size_t O_YP = 0, O_YS = 16777216, O_AK = 83886080, O_AV = 92274688, O_BK = 100663296, O_BV = 117440512, O_CK = 134217728, O_CV = 150994944;

constexpr size_t WS_WTA = 0;
constexpr size_t WS_WTB = WS_WTA + 41943040;
constexpr size_t WS_WTC = WS_WTB + 33554432;
constexpr size_t WS_WTO = WS_WTC + 33554432;
constexpr size_t WS_CACHE = WS_WTO + 33554432;
constexpr size_t WS_PART = WS_CACHE + 41943040;
constexpr size_t WS_MODA = WS_PART + 14155776;
constexpr size_t WS_MODB = WS_MODA + 294912;
constexpr size_t WS_GATE = WS_MODB + 294912;
constexpr size_t WS_ROPE = WS_GATE + 294912;
constexpr size_t WS_MISC = WS_ROPE + 16384;
constexpr size_t WS_H = WS_MISC + 4096;
constexpr size_t WS_QKVG = WS_H + 167772160;
constexpr size_t WS_BAR = WS_QKVG + 671088640;
constexpr size_t WS_END = WS_QKVG + 671088640 + 65536;
constexpr size_t C_AK = 0, C_AV = 2097152, C_BK = 4194304, C_BV = 8388608, C_CK = 12582912, C_CV = 16777216;

struct Params { const float* in[23]; float* out; unsigned char* ws; };

DI unsigned cvtpk(float lo, float hi) { unsigned r; asm volatile("v_cvt_pk_bf16_f32 %0, %1, %2" : "=v"(r) : "v"(lo), "v"(hi)); return r; }
DI float bf_lo(unsigned w) { return __uint_as_float(w << 16); }
DI float bf_hi(unsigned w) { return __uint_as_float(w & 0xffff0000u); }
DI float bf2f(bf16_t x) { return __uint_as_float((unsigned)x << 16); }
DI float silu_f(float g) { return g / (1.f + __expf(-g)); }
DI float shx(float v, int m, int lane) { return __int_as_float(__builtin_amdgcn_ds_bpermute((lane ^ m) << 2, __float_as_int(v))); }

DI int hd_phys(int e) { const int a = e >> 6, half = (e >> 5) & 1, f = e & 31, pi = 32 * a + f; return 8 * (pi >> 2) + 2 * (pi & 3) + half; }

namespace pg8 {
constexpr int BM = 256, BK = 64, HALF = 128, HTB = HALF * BK * 2, STAGE_BYTES = 8 * HTB, NXCD = 8, WGM = 8;
DI int lds_byte(int r, int c) { const int st = (r >> 4) * 2 + (c >> 5), rr = r & 15, cc = c & 31, ob = rr * 64 + cc * 2; return st * 1024 + (ob ^ (((ob >> 9) & 1) << 5)); }
DI void stage_rc(int b, int& R, int& C) { const int st = b / 1024, sb = b % 1024, swz = sb ^ (((sb >> 9) & 1) << 5); R = (st >> 1) * 16 + swz / 64; C = (st & 1) * 32 + (swz % 64) / 2; }
DI int perm32(int rho) { const int n = rho >> 4, i = rho & 15; return 8 * (i >> 2) + 4 * n + (i & 3); }
struct Unit { int pm, pn; };
struct Gemm { const bf16_t* A; const bf16_t* Bt; int M, N, K; };
struct StaticOrder {
    int nM, nN, nwg, G, c;
    DI void init(int M, int N, int G_, int c_) { nM = M / BM; nN = N / BM; nwg = nM * nN; G = G_; c = c_; }
    DI bool next(int i, Unit& u) const {
        const long L = (long)i * G + c; if (L >= nwg) return false;
        int wgid = (int)L; { const int q = nwg / NXCD, r = nwg % NXCD, xcd = wgid % NXCD, off = wgid / NXCD; wgid = (xcd < r ? xcd * (q + 1) : r * (q + 1) + (xcd - r) * q) + off; }
        const int nig = WGM * nN, gid = wgid / nig, fm = gid * WGM, gsz = (nM - fm) < WGM ? (nM - fm) : WGM;
        u.pm = fm + ((wgid % nig) % gsz); u.pn = (wgid % nig) / gsz; return true;
    }
};

struct EpiQKVG {
    static constexpr bool PERM = true;
    bf16_t* O; int ldc; int nqk, nv0, nv1; const float* qg; const float* kg; const float* cosT; int do_rope; float* kout; float* vout; int kindA, jdx;
    DI void operator()(const f32x4 (&acc)[2][2][4][2], const Unit& u, int wr, int wc, int fr, int fq, LAS unsigned char* lds) const {
        { int ln_; asm volatile("v_mbcnt_lo_u32_b32 %0, -1, 0\n\tv_mbcnt_hi_u32_b32 %0, -1, %0" : "=v"(ln_)); fr = ln_ & 15; fq = ln_ >> 4; }
        const int row0 = u.pm * BM + wr * 64 + fr; const int col0 = u.pn * BM + wc * 32 + 8 * fq;
        const bool ctx = u.pm < 32;
        if (u.pn >= nqk) {
            const bool vt = ctx && u.pn >= nv0 && u.pn < nv1;
#pragma unroll
            for (int ai = 0; ai < 2; ++ai)
#pragma unroll
                for (int m = 0; m < 4; ++m) { const int row = row0 + ai * HALF + m * 16; bf16_t* rowp = O + (size_t)row * ldc + col0;
#pragma unroll
                    for (int bj = 0; bj < 2; ++bj) { const f32x4 v0 = acc[ai][bj][m][0], v1 = acc[ai][bj][m][1];
                        u32x4 w; w.x = cvtpk(v0[0], v0[1]); w.y = cvtpk(v0[2], v0[3]); w.z = cvtpk(v1[0], v1[1]); w.w = cvtpk(v1[2], v1[3]);
                        *(u32x4*)(rowp + bj * HALF) = w;
                        if (vt) { const int vc = col0 + bj * HALF - nv0 * BM;
                            float* d = kindA ? vout + ((size_t)((u.pm * 2 + jdx) * 256 + (row & 255))) * 512 + vc : vout + (size_t)row * 2048 + vc;
                            *(f32x4*)d = v0; *(f32x4*)(d + 4) = v1; } } }
            return;
        }
        const int L = wc * 4 + fq, ax = L >> 3, f0 = (L & 7) * 4;
        const float* gs = (u.pn < 8) ? qg : kg;
        const f32x4 g0 = *(const f32x4*)(gs + 64 * ax + f0), g1 = *(const f32x4*)(gs + 64 * ax + 32 + f0);
        LAS float* part = (LAS float*)(lds + 131072);
#pragma unroll
        for (int ai = 0; ai < 2; ++ai)
#pragma unroll
            for (int m = 0; m < 4; ++m)
#pragma unroll
                for (int bj = 0; bj < 2; ++bj) { const f32x4 x0 = acc[ai][bj][m][0], x1 = acc[ai][bj][m][1];
                    float ss = x0[0] * x0[0] + x0[1] * x0[1] + x0[2] * x0[2] + x0[3] * x0[3] + x1[0] * x1[0] + x1[1] * x1[1] + x1[2] * x1[2] + x1[3] * x1[3];
                    ss += shx(ss, 16, fq * 16 + fr); ss += shx(ss, 32, fq * 16 + fr);
                    if (fq == 0) part[(((((wr * 2 + ai) * 4 + m) * 16 + fr) * 2 + bj) << 2) + wc] = ss; }
        asm volatile("s_waitcnt lgkmcnt(0)" ::: "memory"); __builtin_amdgcn_s_barrier(); asm volatile("" ::: "memory");
        const bool rope = (!ctx) && do_rope; const bool kt = ctx && u.pn >= 8;
        f32x4 cs[2][4], sn[2][4];
#pragma unroll
        for (int ai = 0; ai < 2; ++ai)
#pragma unroll
            for (int m = 0; m < 4; ++m) { cs[ai][m] = (f32x4){1.f, 1.f, 1.f, 1.f}; sn[ai][m] = (f32x4){0.f, 0.f, 0.f, 0.f};
                if (rope) { const int row = row0 + ai * HALF + m * 16; const int n = (row - M_CTX) & 4095; const int pos = ax ? (n & 63) : (n >> 6);
                    cs[ai][m] = *(const f32x4*)(cosT + pos * 32 + f0); sn[ai][m] = *(const f32x4*)(cosT + 2048 + pos * 32 + f0); } }
#pragma unroll
        for (int ai = 0; ai < 2; ++ai)
#pragma unroll
            for (int m = 0; m < 4; ++m) { const int row = row0 + ai * HALF + m * 16; bf16_t* rowp = O + (size_t)row * ldc + col0;
                const f32x4 c4 = cs[ai][m], s4 = sn[ai][m];
#pragma unroll
                for (int bj = 0; bj < 2; ++bj) { const f32x4 x0 = acc[ai][bj][m][0], x1 = acc[ai][bj][m][1];
                    const f32x4 pt = *(const LAS f32x4*)(part + (((((wr * 2 + ai) * 4 + m) * 16 + fr) * 2 + bj) << 2));
                    const float rs = rsqrtf((pt[0] + pt[1] + pt[2] + pt[3]) * (1.f / 128.f) + 1e-6f);
                    f32x4 h0 = {x0[0] * rs * g0[0], x0[2] * rs * g0[1], x1[0] * rs * g0[2], x1[2] * rs * g0[3]};
                    f32x4 h1 = {x0[1] * rs * g1[0], x0[3] * rs * g1[1], x1[1] * rs * g1[2], x1[3] * rs * g1[3]};
                    const f32x4 r0 = h0 * c4 - h1 * s4, r1 = h1 * c4 + h0 * s4;
                    u32x4 w; w.x = cvtpk(r0[0], r1[0]); w.y = cvtpk(r0[1], r1[1]); w.z = cvtpk(r0[2], r1[2]); w.w = cvtpk(r0[3], r1[3]);
                    *(u32x4*)(rowp + bj * HALF) = w;
                    if (kt) { const int hk = (u.pn - 8) * 2 + bj;
                        float* d = (kindA ? kout + ((size_t)((u.pm * 2 + jdx) * 256 + (row & 255))) * 512 : kout + (size_t)row * 2048) + hk * 128 + 64 * ax + f0;
                        *(f32x4*)d = r0; *(f32x4*)(d + 32) = r1; } } }
    }
};
struct EpiOut {
    static constexpr bool PERM = false;
    const float* xin_ctx; const float* xin_lat; float* out; const float* gate;
    DI void operator()(const f32x4 (&acc)[2][2][4][2], const Unit& u, int wr, int wc, int fr, int fq, LAS unsigned char*) const {
        const int row0 = u.pm * BM + wr * 64 + fr, col0 = u.pn * BM + wc * 32 + 4 * fq;
        const bool ctx = u.pm < 32; const int r9 = ctx ? 0 : 1 + ((u.pm - 32) >> 4);
        const float* xb = ctx ? xin_ctx : xin_lat; const int rsub = ctx ? 0 : M_CTX;
        f32x4 gv[2][2];
#pragma unroll
        for (int bj = 0; bj < 2; ++bj)
#pragma unroll
            for (int n = 0; n < 2; ++n) gv[bj][n] = *(const f32x4*)(gate + r9 * DM + col0 + bj * HALF + n * 16);
        f32x4 xr_[3][2][2];
#define EPO_LD(g, slot) do { const int _row = row0 + ((g) >> 2) * HALF + ((g) & 3) * 16; const float* _xr = xb + (size_t)(_row - rsub) * DM + col0;      \
        _Pragma("unroll") for (int bj = 0; bj < 2; ++bj) _Pragma("unroll") for (int n = 0; n < 2; ++n) xr_[slot][bj][n] = *(const f32x4*)(_xr + bj * HALF + n * 16); } while (0)
        EPO_LD(0, 0); EPO_LD(1, 1); EPO_LD(2, 2);
#pragma unroll
        for (int g = 0; g < 8; ++g) { const int ai = g >> 2, m = g & 3, slot = g % 3; const int row = row0 + ai * HALF + m * 16; float* orow = out + (size_t)row * DM + col0;
#pragma unroll
            for (int bj = 0; bj < 2; ++bj)
#pragma unroll
                for (int n = 0; n < 2; ++n) *(f32x4*)(orow + bj * HALF + n * 16) = xr_[slot][bj][n] + gv[bj][n] * acc[ai][bj][m][n];
            __builtin_amdgcn_sched_barrier(0);
            if (g + 3 < 8) { if (slot == 0) EPO_LD(g + 3, 0); else if (slot == 1) EPO_LD(g + 3, 1); else EPO_LD(g + 3, 2); }
            __builtin_amdgcn_sched_barrier(0); }
#undef EPO_LD
    }
};

template <class Epi, class Sched>
DI void gemm_phase(LAS unsigned char* lds, const Gemm g, const Sched& S, const Epi& E) {
    int tid_ = threadIdx.x; asm volatile("" : "+v"(tid_));
    const int tid = tid_, wid = __builtin_amdgcn_readfirstlane(tid >> 6), lane = tid & 63, wr = wid >> 2, wc = wid & 3, fr = lane & 15, fq = lane >> 4;
    const int K = g.K, nt = K / BK;
    unsigned voffA[2], voffB[2];
#pragma unroll
    for (int i = 0; i < 2; ++i) { int R, C; stage_rc(tid * 16 + i * 8192, R, C); const int Rb = Epi::PERM ? ((R & ~31) + perm32(R & 31)) : R;
        voffA[i] = (unsigned)(R * K + C) * 2u; voffB[i] = (unsigned)(Rb * K + C) * 2u; }
    const size_t kstep = (size_t)(BK * 2);
    const size_t hstep = (size_t)HALF * K * 2;
    const size_t tstep = 2 * hstep;
    const unsigned ldsw = (unsigned)wid * 1024u;
    const int aoff = lds_byte(wr * 64 + fr, fq * 8), boff = lds_byte(wc * 32 + fr, fq * 8);
#define PG8_SA(b, h) (((b) * 2 + (h)) * HTB)
#define PG8_SB(b, h) ((4 + (b) * 2 + (h)) * HTB)
#define PG8_STAGE(bufoff, gbase, voff) do { _Pragma("unroll") for (int _i = 0; _i < 2; ++_i) \
        __builtin_amdgcn_global_load_lds((const unsigned*)((const char*)(gbase) + (voff)[_i]), (LAS unsigned*)(lds + (bufoff) + ldsw + _i * 8192), 16, 0, 0); } while (0)
#define PG8_LDA(dst, b, h) do { _Pragma("unroll") for (int m = 0; m < 4; ++m) _Pragma("unroll") for (int k = 0; k < 2; ++k) dst[m][k] = *(const LAS bf16x8*)(lds + PG8_SA(b, h) + aoff + m * 2048 + k * 1024); } while (0)
#define PG8_LDB(dst, b, h) do { _Pragma("unroll") for (int n = 0; n < 2; ++n) _Pragma("unroll") for (int k = 0; k < 2; ++k) dst[n][k] = *(const LAS bf16x8*)(lds + PG8_SB(b, h) + boff + n * 2048 + k * 1024); } while (0)
#define PG8_MMA(ai, bj, At, Bt) do { __builtin_amdgcn_s_setprio(1); _Pragma("unroll") for (int m = 0; m < 4; ++m) _Pragma("unroll") for (int n = 0; n < 2; ++n) _Pragma("unroll") for (int k = 0; k < 2; ++k) \
        acc[ai][bj][m][n] = __builtin_amdgcn_mfma_f32_16x16x32_bf16(Bt[n][k], At[m][k], acc[ai][bj][m][n], 0, 0, 0); __builtin_amdgcn_s_setprio(0); } while (0)
#define PG8_WAIT_V(n) asm volatile("s_waitcnt vmcnt(" #n ")" ::: "memory")
#define PG8_WAIT_L(n) asm volatile("s_waitcnt lgkmcnt(" #n ")" ::: "memory")
#define PG8_BAR __builtin_amdgcn_s_barrier()
#define PG8_SCHED __builtin_amdgcn_sched_barrier(0)
    Unit cur, nxt; int ui = 0;
    if (!S.next(0, cur)) return;
    f32x4 acc[2][2][4][2];
#pragma unroll
    for (int a = 0; a < 2; ++a)
#pragma unroll
        for (int b = 0; b < 2; ++b)
#pragma unroll
            for (int m = 0; m < 4; ++m)
#pragma unroll
                for (int n = 0; n < 2; ++n) acc[a][b][m][n] = (f32x4){0.f, 0.f, 0.f, 0.f};
    bf16x8 At[4][2], B0[2][2], B1[2][2];
    const char* cA = (const char*)g.A + (size_t)cur.pm * tstep; const char* cB = (const char*)g.Bt + (size_t)cur.pn * tstep;
    PG8_STAGE(PG8_SB(0, 0), cB, voffB); PG8_STAGE(PG8_SA(0, 0), cA, voffA); PG8_STAGE(PG8_SB(0, 1), cB + hstep, voffB); PG8_STAGE(PG8_SA(0, 1), cA + hstep, voffA);
    if (wr == 1) PG8_BAR;
    PG8_WAIT_V(4); PG8_BAR;
    PG8_STAGE(PG8_SB(1, 0), cB + kstep, voffB); PG8_STAGE(PG8_SA(1, 0), cA + kstep, voffA); PG8_STAGE(PG8_SB(1, 1), cB + hstep + kstep, voffB);
    PG8_WAIT_V(6); PG8_BAR;
    for (;;) {
        const bool has_next = S.next(ui + 1, nxt);
        const char* nA = has_next ? (const char*)g.A + (size_t)nxt.pm * tstep : cA; const char* nB = has_next ? (const char*)g.Bt + (size_t)nxt.pn * tstep : cB;
        for (int t = 0; t < nt; t += 2) {
            const bool last = (t == nt - 2);
            const char* a1 = cA + (size_t)(t + 1) * kstep;
            const char* a2 = last ? nA : cA + (size_t)(t + 2) * kstep; const char* b2 = last ? nB : cB + (size_t)(t + 2) * kstep;
            const char* a3 = a2 + kstep; const char* b3 = b2 + kstep;
            PG8_LDB(B0, 0, 0); PG8_SCHED; PG8_LDA(At, 0, 0); PG8_STAGE(PG8_SA(1, 1), a1 + hstep, voffA);
            PG8_WAIT_L(8); PG8_BAR; PG8_WAIT_L(0); PG8_MMA(0, 0, At, B0); PG8_BAR; PG8_SCHED;
            PG8_LDB(B1, 0, 1); PG8_STAGE(PG8_SB(0, 0), b2, voffB);
            PG8_BAR; PG8_WAIT_L(0); PG8_MMA(0, 1, At, B1); PG8_BAR;
            PG8_LDA(At, 0, 1); PG8_STAGE(PG8_SA(0, 0), a2, voffA);
            PG8_BAR; PG8_WAIT_L(0); PG8_MMA(1, 0, At, B0); PG8_BAR; PG8_SCHED;
            PG8_STAGE(PG8_SB(0, 1), b2 + hstep, voffB);
            PG8_WAIT_V(6); PG8_BAR; PG8_MMA(1, 1, At, B1); PG8_BAR;
            PG8_LDB(B0, 1, 0); PG8_SCHED; PG8_LDA(At, 1, 0); PG8_STAGE(PG8_SA(0, 1), a2 + hstep, voffA);
            PG8_WAIT_L(8); PG8_BAR; PG8_WAIT_L(0); PG8_MMA(0, 0, At, B0); PG8_BAR; PG8_SCHED;
            PG8_LDB(B1, 1, 1); PG8_STAGE(PG8_SB(1, 0), b3, voffB);
            PG8_BAR; PG8_WAIT_L(0); PG8_MMA(0, 1, At, B1); PG8_BAR;
            PG8_LDA(At, 1, 1); PG8_STAGE(PG8_SA(1, 0), a3, voffA);
            PG8_BAR; PG8_WAIT_L(0); PG8_MMA(1, 0, At, B0); PG8_BAR; PG8_SCHED;
            PG8_STAGE(PG8_SB(1, 1), b3 + hstep, voffB);
            PG8_WAIT_V(6); PG8_BAR; PG8_MMA(1, 1, At, B1); PG8_BAR;
        }
        E(acc, cur, wr, wc, fr, fq, lds);
        if (!has_next) break;
#pragma unroll
        for (int a = 0; a < 2; ++a)
#pragma unroll
            for (int b = 0; b < 2; ++b)
#pragma unroll
                for (int m = 0; m < 4; ++m)
#pragma unroll
                    for (int n = 0; n < 2; ++n) acc[a][b][m][n] = (f32x4){0.f, 0.f, 0.f, 0.f};
        cur = nxt; cA = nA; cB = nB; ++ui;
    }
    PG8_WAIT_V(0);
    if (wr == 0) PG8_BAR;
    PG8_BAR;
#undef PG8_SA
#undef PG8_SB
#undef PG8_STAGE
#undef PG8_LDA
#undef PG8_LDB
#undef PG8_MMA
#undef PG8_WAIT_V
#undef PG8_WAIT_L
#undef PG8_BAR
#undef PG8_SCHED
}
}

constexpr float THR = 8.f;
constexpr int STG = 16384;
constexpr int KST_OFF = 0, VST_OFF = 65536, WSL_OFF = 131072, RPB_OFF = 133120;
#define KSWZ(row, colB) ((row) * 256 + ((colB) ^ (((row) & 7) << 4)))
#define SBAR() __builtin_amdgcn_sched_barrier(0)
DI int crow(int r, int hi) { return (r & 3) + 8 * (r >> 2) + 4 * hi; }

struct AttnArgs {
    const bf16_t* Q; long ldq;
    const bf16_t* K0; const bf16_t* V0; long ld0; int n0;
    const bf16_t* K1; const bf16_t* V1; long ld1; int n1; int s1_start, s1_max;
    int mode;
    int qpos0, r0, rbase;
    int has_sink; float sinkl2;
    int out_mode;
    bf16_t* O; long ldo; const bf16_t* Gp; long ldg;
    int fuse; const float* subln; float lam;
};

DI void apply_mask(f32x16& p0, f32x16& p1, const AttnArgs& a, int j, int wid, int r32, int hi, const LAS float* rpbL) {
    if (a.mode == 0 || j < a.n0) return;
    { int l2 = r32 | (hi << 5); asm volatile("" : "+v"(l2)); r32 = l2 & 31; hi = l2 >> 5; }
    const int jl = j - a.n0;
#ifndef ATT_NOMODE1
    if (a.mode == 1) {
        const int kbase = a.s1_start + jl * 64;
        const bool tv = (kbase >= 0) && (kbase < 4096);
        int dqh = tv ? (kbase - (a.qpos0 + wid * 32 + r32) + 4 * hi + 128) : 1000000;
        asm volatile("" : "+v"(dqh));
#pragma unroll
        for (int r = 0; r < 16; ++r) { const int cq = (r & 3) + 8 * (r >> 2);
            p0[r] = ((unsigned)(dqh + cq) <= 256u) ? p0[r] : -1e30f;
            p1[r] = ((unsigned)(dqh + cq + 32) <= 256u) ? p1[r] : -1e30f; }
    }
#else
    if (0) {}
#endif
#ifndef ATT_NOMODE2
    else {
        const int kr = a.rbase + jl, r = a.r0 + (wid >> 1); const int rs = min(max(r - 4, 0), 56);
        const bool tv = (kr >= rs) && (kr < rs + 8);
        if (!tv) {
#pragma unroll
            for (int q = 0; q < 16; ++q) { p0[q] = -1e30f; p1[q] = -1e30f; }
        } else {
            const int c = (wid & 1) * 32 + r32; const int cs = min(max(c - 8, 0), 48);
            int tq = 4 * hi - cs;
            int bidx = (kr - r + 7) * 31 + 15 - c + 4 * hi;
            asm volatile("" : "+v"(tq), "+v"(bidx));
            const LAS float* bp = rpbL + bidx;
#pragma unroll
            for (int q = 0; q < 16; ++q) { const int cq = (q & 3) + 8 * (q >> 2);
                const float b0 = bp[cq], b1 = bp[cq + 32];
                p0[q] = ((unsigned)(tq + cq) < 16u) ? p0[q] + b0 : -1e30f; p1[q] = ((unsigned)(tq + cq + 32) < 16u) ? p1[q] + b1 : -1e30f;
                if ((q & 3) == 3) SBAR(); }
        }
    }
#endif
}
DI bool tile_dead(const AttnArgs& a, int j, int wid) {
    if (a.mode == 0 || j < a.n0) return false;
    const int jl = j - a.n0;
    if (a.mode == 1) { const int kbase = a.s1_start + jl * 64, qlo = a.qpos0 + wid * 32;
        return !((kbase >= 0) && (kbase < 4096) && (kbase + 63 >= qlo - 128) && (kbase <= qlo + 31 + 128)); }
    const int kr = a.rbase + jl, r = a.r0 + (wid >> 1); const int rs = min(max(r - 4, 0), 56);
    return !((kr >= rs) && (kr < rs + 8));
}
DI void partialSM(f32x16& p0, f32x16& p1, float& m_reg, float& mn, float& alpha) {
    constexpr float C = SCALE * LOG2E;
    float pmax = p0[0];
#pragma unroll
    for (int r = 1; r < 16; ++r) pmax = fmaxf(pmax, p0[r]);
#pragma unroll
    for (int r = 0; r < 16; ++r) pmax = fmaxf(pmax, p1[r]);
    { auto rr = __builtin_amdgcn_permlane32_swap(__float_as_uint(pmax), __float_as_uint(pmax), false, false);
      pmax = fmaxf(__uint_as_float(rr[0]), __uint_as_float(rr[1])); }
    if (__builtin_expect(__all(pmax - m_reg <= THR / SCALE), 1)) { mn = m_reg; alpha = 1.f; }
    else { mn = fmaxf(m_reg, pmax); alpha = __builtin_amdgcn_exp2f((m_reg - mn) * C); m_reg = mn; }
    const float mnC = -mn * C;
#pragma unroll
    for (int r = 0; r < 16; ++r) p0[r] = fmaf(p0[r], C, mnC);
#pragma unroll
    for (int r = 0; r < 16; ++r) p1[r] = fmaf(p1[r], C, mnC);
#pragma unroll
    for (int r = 0; r < 16; ++r) p0[r] = __builtin_amdgcn_exp2f(p0[r]);
}
DI void finishSM(f32x16& p0, f32x16& p1, float alpha, float& l_reg, bf16x8& pa0, bf16x8& pa1, bf16x8& pa2, bf16x8& pa3) {
#pragma unroll
    for (int r = 0; r < 16; ++r) p1[r] = __builtin_amdgcn_exp2f(p1[r]);
    float ps = 0;
#pragma unroll
    for (int r = 0; r < 16; ++r) ps += p0[r];
#pragma unroll
    for (int r = 0; r < 16; ++r) ps += p1[r];
    { auto rr = __builtin_amdgcn_permlane32_swap(__float_as_uint(ps), __float_as_uint(ps), false, false);
      ps = __uint_as_float(rr[0]) + __uint_as_float(rr[1]); }
    l_reg = l_reg * alpha + ps;
#define PK4(P, BASE, OUT) do { unsigned a0 = cvtpk(P[BASE + 0], P[BASE + 1]), a1 = cvtpk(P[BASE + 2], P[BASE + 3]);   \
    unsigned b0 = cvtpk(P[BASE + 4], P[BASE + 5]), b1 = cvtpk(P[BASE + 6], P[BASE + 7]);                              \
    auto r0 = __builtin_amdgcn_permlane32_swap(a0, b0, false, false); auto r1 = __builtin_amdgcn_permlane32_swap(a1, b1, false, false); \
    u32x4 w = {r0[0], r1[0], r0[1], r1[1]}; OUT = *reinterpret_cast<bf16x8*>(&w); } while (0)
    PK4(p0, 0, pa0); PK4(p0, 8, pa1); PK4(p1, 0, pa2); PK4(p1, 8, pa3);
#undef PK4
}
DI void qkt(f32x16& p0, f32x16& p1, const LAS unsigned char* Ks, const bf16x8* qr, int r32, int hi) {
    p0 = f32x16{}; p1 = f32x16{};
    { int l2 = r32 | (hi << 5); asm volatile("" : "+v"(l2)); r32 = l2 & 31; hi = l2 >> 5; }
#pragma unroll
    for (int d0 = 0; d0 < 8; ++d0) { const int cb = (d0 * 16 + hi * 8) * 2;
        bf16x8 b0 = *reinterpret_cast<const LAS bf16x8*>(Ks + KSWZ(r32, cb));
        bf16x8 b1 = *reinterpret_cast<const LAS bf16x8*>(Ks + KSWZ(32 + r32, cb));
        p0 = __builtin_amdgcn_mfma_f32_32x32x16_bf16(b0, qr[d0], p0, 0, 0, 0);
        p1 = __builtin_amdgcn_mfma_f32_32x32x16_bf16(b1, qr[d0], p1, 0, 0, 0);
        if (d0 == 3) SBAR(); }
}
DI int v_st(int k, int c) { const int kk = (k & ~0xC) | ((k & 4) << 1) | ((k & 8) >> 1); return ((kk >> 3) * 4 + (c >> 5)) * 512 + ((kk & 7) * 32 + (c & 31)) * 2; }
DI int v_rd_base(int lane) { return ((lane & 3) << 3) | (((lane >> 2) & 3) << 6) | (((lane >> 4) & 1) << 5) | (((lane >> 5) & 1) << 8); }
constexpr int v_rd_off(int d0, int ks, int half) { return d0 * 512 + ks * 4096 + half * 2048; }
template <int OFF> DI s16x4 tr_read(int vb) {
    s16x4 r; asm volatile("ds_read_b64_tr_b16 %0, %1 offset:%2" : "=&v"(r) : "v"(vb), "i"(OFF) : "memory"); return r;
}
template <int D0> DI void pv_one(f32x16& od, int vb, bf16x8 pa0, bf16x8 pa1, bf16x8 pa2, bf16x8 pa3) {
    const s16x4 l0 = tr_read<v_rd_off(D0, 0, 0)>(vb), h0 = tr_read<v_rd_off(D0, 0, 1)>(vb), l1 = tr_read<v_rd_off(D0, 1, 0)>(vb), h1 = tr_read<v_rd_off(D0, 1, 1)>(vb);
    const s16x4 l2 = tr_read<v_rd_off(D0, 2, 0)>(vb), h2 = tr_read<v_rd_off(D0, 2, 1)>(vb), l3 = tr_read<v_rd_off(D0, 3, 0)>(vb), h3 = tr_read<v_rd_off(D0, 3, 1)>(vb);
    asm volatile("s_waitcnt lgkmcnt(0)" ::: "memory"); SBAR();
#define PK(L, H) (bf16x8){L[0], L[1], L[2], L[3], H[0], H[1], H[2], H[3]}
    od = __builtin_amdgcn_mfma_f32_32x32x16_bf16(pa0, PK(l0, h0), od, 0, 0, 0);
    od = __builtin_amdgcn_mfma_f32_32x32x16_bf16(pa1, PK(l1, h1), od, 0, 0, 0);
    od = __builtin_amdgcn_mfma_f32_32x32x16_bf16(pa2, PK(l2, h2), od, 0, 0, 0);
    od = __builtin_amdgcn_mfma_f32_32x32x16_bf16(pa3, PK(l3, h3), od, 0, 0, 0);
#undef PK
}
#define PV_RD(S, D0, VB) const s16x4 S##l0 = tr_read<v_rd_off(D0, 0, 0)>(VB), S##h0 = tr_read<v_rd_off(D0, 0, 1)>(VB), S##l1 = tr_read<v_rd_off(D0, 1, 0)>(VB), S##h1 = tr_read<v_rd_off(D0, 1, 1)>(VB), \
                               S##l2 = tr_read<v_rd_off(D0, 2, 0)>(VB), S##h2 = tr_read<v_rd_off(D0, 2, 1)>(VB), S##l3 = tr_read<v_rd_off(D0, 3, 0)>(VB), S##h3 = tr_read<v_rd_off(D0, 3, 1)>(VB)
#define PV_PK(L, H) (bf16x8){L[0], L[1], L[2], L[3], H[0], H[1], H[2], H[3]}
#define PV_MM(S, OD) do { OD = __builtin_amdgcn_mfma_f32_32x32x16_bf16(pa0, PV_PK(S##l0, S##h0), OD, 0, 0, 0); OD = __builtin_amdgcn_mfma_f32_32x32x16_bf16(pa1, PV_PK(S##l1, S##h1), OD, 0, 0, 0); \
                          OD = __builtin_amdgcn_mfma_f32_32x32x16_bf16(pa2, PV_PK(S##l2, S##h2), OD, 0, 0, 0); OD = __builtin_amdgcn_mfma_f32_32x32x16_bf16(pa3, PV_PK(S##l3, S##h3), OD, 0, 0, 0); } while (0)
#define PV_W8() do { asm volatile("s_waitcnt lgkmcnt(8)" ::: "memory"); SBAR(); } while (0)
#define PV_W0() do { asm volatile("s_waitcnt lgkmcnt(0)" ::: "memory"); SBAR(); } while (0)
template <int NH> DI void pv_pipe(f32x16* o, int vb, bf16x8 pa0, bf16x8 pa1, bf16x8 pa2, bf16x8 pa3) {
    SBAR();
    { PV_RD(a, 0, vb); SBAR();
      { PV_RD(b, 1, vb); PV_W8(); PV_MM(a, o[0]); SBAR();
        { PV_RD(c, 2, vb); PV_W8(); PV_MM(b, o[1]); SBAR();
          { PV_RD(d, 3, vb); PV_W8(); PV_MM(c, o[2]); SBAR();
            if constexpr (NH == 1) { PV_W0(); PV_MM(d, o[3]); SBAR(); }
            else { const int vb2 = vb + STG;
              { PV_RD(e, 0, vb2); PV_W8(); PV_MM(d, o[3]); SBAR();
                { PV_RD(f, 1, vb2); PV_W8(); PV_MM(e, o[4]); SBAR();
                  { PV_RD(g, 2, vb2); PV_W8(); PV_MM(f, o[5]); SBAR();
                    { PV_RD(h, 3, vb2); PV_W8(); PV_MM(g, o[6]); SBAR();
                      PV_W0(); PV_MM(h, o[7]); SBAR(); } } } } } } } } }
}
DI void pv_d0(f32x16* o, int vb, bf16x8 pa0, bf16x8 pa1, bf16x8 pa2, bf16x8 pa3) { pv_pipe<1>(o, vb, pa0, pa1, pa2, pa3); }

DI void attn_body(const AttnArgs& a, LAS unsigned char* lds) {
    int tid_ = threadIdx.x; asm volatile("" : "+v"(tid_));
    const int tid = tid_, wid = __builtin_amdgcn_readfirstlane(tid >> 6), lane = tid & 63, r32 = lane & 31, hi = lane >> 5;
    LAS unsigned char* Kst = lds + KST_OFF; LAS unsigned char* Vst = lds + VST_OFF;
    LAS float* wsl = (LAS float*)(lds + WSL_OFF) + wid * 64; LAS float* li_l = wsl; LAS float* al_l = wsl + 32;
    const LAS float* rpbL = (const LAS float*)(lds + RPB_OFF);
    float m_reg = -1e30f, l_reg = 0; f32x16 o[4] = {}; bf16x8 qr[8];
    const bf16_t* Qw = a.Q + (long)(wid * 32 + r32) * a.ldq + hi * 8;
#pragma unroll
    for (int d0 = 0; d0 < 8; ++d0) qr[d0] = *reinterpret_cast<const bf16x8*>(Qw + d0 * 16);
    const int vb0 = (int)(size_t)Vst + v_rd_base(lane);
#define ISSUE(jt, ST) do { const int _j = (jt); const char* _k; const char* _v; unsigned _ld;                                   \
    if (_j < a.n0) { _ld = (unsigned)a.ld0 * 2u; const size_t _o = (size_t)_j * 64 * _ld; _k = (const char*)a.K0 + _o; _v = (const char*)a.V0 + _o; }                         \
    else { int _st = a.s1_start + (_j - a.n0) * 64; _st = max(0, min(_st, a.s1_max)); _ld = (unsigned)a.ld1 * 2u; const size_t _o = (size_t)_st * _ld; _k = (const char*)a.K1 + _o; _v = (const char*)a.V1 + _o; } \
    unsigned _ln = (unsigned)lane; asm volatile("" : "+v"(_ln));                                                                  \
    _Pragma("unroll") for (int _i = 0; _i < 2; ++_i) { const unsigned _s = (unsigned)((wid * 2 + _i) * 64) + _ln;                 \
        const unsigned _rk = _s >> 4, _ck = ((_s & 15u) << 4) ^ ((_rk & 7u) << 4);                                                \
        const unsigned _sub = _s >> 5, _w5 = _s & 31u, _kk = (_sub >> 2) * 8u + (_w5 >> 2);                                         \
        const unsigned _rv = (_kk & ~0xCu) | ((_kk & 4u) << 1) | ((_kk & 8u) >> 1), _cv = ((_sub & 3u) * 32u + (_w5 & 3u) * 8u) * 2u; \
        unsigned _ok = _rk * _ld + _ck, _ov = _rv * _ld + _cv; asm volatile("" : "+v"(_ok), "+v"(_ov));                           \
        __builtin_amdgcn_global_load_lds((const unsigned*)(_k + _ok), (LAS unsigned*)(Kst + (ST) * STG + (wid * 2 + _i) * 1024), 16, 0, 0); \
        __builtin_amdgcn_global_load_lds((const unsigned*)(_v + _ov), (LAS unsigned*)(Vst + (ST) * STG + (wid * 2 + _i) * 1024), 16, 0, 0); } } while (0)
#define WAITV(n) asm volatile("s_waitcnt vmcnt(" #n ")" ::: "memory")
#define BAR() do { asm volatile("s_waitcnt lgkmcnt(0)" ::: "memory"); __builtin_amdgcn_s_barrier(); asm volatile("" ::: "memory"); SBAR(); } while (0)
#define RESC(al) do { if (__any((al) < 1.f)) { if (hi == 0) al_l[r32] = (al); asm volatile("s_waitcnt lgkmcnt(0)" ::: "memory"); \
    _Pragma("unroll") for (int d = 0; d < 4; ++d) _Pragma("unroll") for (int r = 0; r < 16; ++r) o[d][r] *= al_l[crow(r, hi)]; } } while (0)
    f32x16 pA0, pA1, pB0, pB1; float mnA, mnB, alA, alB; bf16x8 pa0, pa1, pa2, pa3; const int NT = a.n0 + a.n1;
#define STEP(X0, X1, mnX, alX, deadX, Y0, Y1, alY, deadY, jt, KS, VS) do { const int _jj = (jt);                                    \
    deadX = tile_dead(a, _jj, wid);                                                                                               \
    SBAR(); if (!deadX) qkt(X0, X1, Kst + (KS) * STG, qr, r32, hi);                                                               \
    else { _Pragma("unroll") for (int _q = 0; _q < 16; ++_q) { X0[_q] = -1e30f; X1[_q] = -1e30f; } }                              \
    SBAR();                                                                                                                       \
    if (!deadY) finishSM(Y0, Y1, alY, l_reg, pa0, pa1, pa2, pa3);                                                                 \
    SBAR();                                                                                                                       \
    if (_jj + 2 < NT) ISSUE(_jj + 2, ((KS) + 2) & 3);                                                                             \
    SBAR();                                                                                                                       \
    if (!deadY) pv_d0(o, vb0 + (VS) * STG, pa0, pa1, pa2, pa3);                                                                   \
    SBAR(); if (!deadX) { apply_mask(X0, X1, a, _jj, wid, r32, hi, rpbL); SBAR(); partialSM(X0, X1, m_reg, mnX, alX); RESC(alX); } \
    if (_jj + 2 < NT) WAITV(4); else WAITV(0);                                                                                    \
    BAR(); } while (0)
    bool deadA = false, deadB = false;
    ISSUE(0, 0); ISSUE(1, 1);
    WAITV(4); BAR();
    SBAR(); qkt(pA0, pA1, Kst, qr, r32, hi); SBAR();
    ISSUE(2, 2);
    SBAR(); apply_mask(pA0, pA1, a, 0, wid, r32, hi, rpbL); partialSM(pA0, pA1, m_reg, mnA, alA);
    WAITV(4); BAR();
#pragma unroll 1
    for (int j = 1; j < NT; j += 4) {
        STEP(pB0, pB1, mnB, alB, deadB, pA0, pA1, alA, deadA, j, 1, 0);
        STEP(pA0, pA1, mnA, alA, deadA, pB0, pB1, alB, deadB, j + 1, 2, 1);
        STEP(pB0, pB1, mnB, alB, deadB, pA0, pA1, alA, deadA, j + 2, 3, 2);
        if (j + 3 < NT) STEP(pA0, pA1, mnA, alA, deadA, pB0, pB1, alB, deadB, j + 3, 0, 3);
    }
    if (!deadB) { finishSM(pB0, pB1, alB, l_reg, pa0, pa1, pa2, pa3); SBAR();
        pv_d0(o, vb0 + 3 * STG, pa0, pa1, pa2, pa3); }
    if (a.has_sink) l_reg += __builtin_amdgcn_exp2f(a.sinkl2 - m_reg * (SCALE * LOG2E));
    if (hi == 0) li_l[r32] = l_reg; asm volatile("s_waitcnt lgkmcnt(0)" ::: "memory");
    float rli[16];
#pragma unroll
    for (int r = 0; r < 16; ++r) rli[r] = __builtin_amdgcn_rcpf(li_l[crow(r, hi)]);
    {
        int wu = wid; unsigned rl = (unsigned)r32 * 2u;
        asm volatile("" : "+s"(wu), "+v"(rl));
        char* Ow = (char*)(a.O + (size_t)(wu * 32) * a.ldo); const char* Gw = (const char*)(a.Gp + (size_t)(wu * 32) * a.ldg);
        const unsigned ldo2 = (unsigned)a.ldo * 2u, ldg2 = (unsigned)a.ldg * 2u;
        if (a.out_mode == 0) {
            BAR();
            unsigned ln = (unsigned)lane; asm volatile("" : "+v"(ln));
            u32x4 gw[8];
#pragma unroll
            for (int i = 0; i < 8; ++i) { const unsigned c = (unsigned)i * 64u + ln; gw[i] = *(const u32x4*)(Gw + (c >> 4) * ldg2 + (c & 15u) * 16u); }
            LAS float* img = (LAS float*)(lds + (unsigned)wu * 16384u);
            const unsigned wbase = (unsigned)hi * 4u * 128u + (ln & 31u);
#pragma unroll
            for (int r = 0; r < 16; ++r) { const unsigned ro = wbase + (unsigned)((r & 3) + 8 * (r >> 2)) * 128u;
                img[ro] = o[0][r] * rli[r]; img[ro + 32] = o[1][r] * rli[r]; img[ro + 64] = o[2][r] * rli[r]; img[ro + 96] = o[3][r] * rli[r]; }
            asm volatile("s_waitcnt lgkmcnt(0)" ::: "memory");
#pragma unroll
            for (int i = 0; i < 8; ++i) { const unsigned c = (unsigned)i * 64u + ln; const unsigned row = c >> 4, c8 = (c & 15u) * 8u;
                const f32x4 x0 = *(const LAS f32x4*)(img + row * 128u + c8), x1 = *(const LAS f32x4*)(img + row * 128u + c8 + 4);
                const u32x4 g = gw[i]; u32x4 w;
                w.x = cvtpk(x0[0] * silu_f(bf_lo(g.x)), x0[1] * silu_f(bf_hi(g.x))); w.y = cvtpk(x0[2] * silu_f(bf_lo(g.y)), x0[3] * silu_f(bf_hi(g.y)));
                w.z = cvtpk(x1[0] * silu_f(bf_lo(g.z)), x1[1] * silu_f(bf_hi(g.z))); w.w = cvtpk(x1[2] * silu_f(bf_lo(g.w)), x1[3] * silu_f(bf_hi(g.w)));
                *(u32x4*)(Ow + row * ldo2 + c8 * 2u) = w; }
        } else {
#pragma unroll
            for (int r = 0; r < 16; ++r) { const unsigned orow = (unsigned)crow(r, hi); const unsigned oo = orow * ldo2 + rl;
                const float v0 = o[0][r] * rli[r], v1 = o[1][r] * rli[r], v2 = o[2][r] * rli[r], v3 = o[3][r] * rli[r];
                *(bf16_t*)(Ow + oo) = (bf16_t)(cvtpk(v0, 0.f) & 0xffffu); *(bf16_t*)(Ow + oo + 64) = (bf16_t)(cvtpk(v1, 0.f) & 0xffffu);
                *(bf16_t*)(Ow + oo + 128) = (bf16_t)(cvtpk(v2, 0.f) & 0xffffu); *(bf16_t*)(Ow + oo + 192) = (bf16_t)(cvtpk(v3, 0.f) & 0xffffu); }
        }
    }
#undef ISSUE
#undef WAITV
#undef BAR
#undef RESC
#undef STEP
}

constexpr int BK_OFF = 0, BV_OFF = 49152, BWSL_OFF = 147456;
DI void attn_body_b(const AttnArgs& a, LAS unsigned char* lds) {
    int tid_ = threadIdx.x; asm volatile("" : "+v"(tid_));
    const int tid = tid_, wid = __builtin_amdgcn_readfirstlane(tid >> 6), lane = tid & 63, r32 = lane & 31, hi = lane >> 5;
    LAS unsigned char* Kst = lds + BK_OFF; LAS unsigned char* Vst = lds + BV_OFF;
    LAS float* wsl = (LAS float*)(lds + BWSL_OFF) + wid * 64; LAS float* li_l = wsl; LAS float* al_l = wsl + 32;
    float m_reg = -1e30f, l_reg = 0; f32x16 o[8] = {}; bf16x8 qr[8];
    const bf16_t* Qw = a.Q + (long)(wid * 32 + r32) * a.ldq + hi * 8;
#pragma unroll
    for (int d0 = 0; d0 < 8; ++d0) qr[d0] = *reinterpret_cast<const bf16x8*>(Qw + d0 * 16);
    const int vb0 = (int)(size_t)Vst + v_rd_base(lane);
#define ISSUEB(jt, ST) do { const int _j = (jt); const char* _k; const char* _v; unsigned _ld;                                   \
    if (_j < a.n0) { _ld = (unsigned)a.ld0 * 2u; const size_t _o = (size_t)_j * 64 * _ld; _k = (const char*)a.K0 + _o; _v = (const char*)a.V0 + _o; }                         \
    else { int _st = a.s1_start + (_j - a.n0) * 64; _st = max(0, min(_st, a.s1_max)); _ld = (unsigned)a.ld1 * 2u; const size_t _o = (size_t)_st * _ld; _k = (const char*)a.K1 + _o; _v = (const char*)a.V1 + _o; } \
    unsigned _ln = (unsigned)lane; asm volatile("" : "+v"(_ln));                                                                  \
    _Pragma("unroll") for (int _i = 0; _i < 2; ++_i) { const unsigned _s = (unsigned)((wid * 2 + _i) * 64) + _ln;                 \
        const unsigned _rk = _s >> 4, _ck = ((_s & 15u) << 4) ^ ((_rk & 7u) << 4);                                                \
        const unsigned _sub = _s >> 5, _w5 = _s & 31u, _kk = (_sub >> 2) * 8u + (_w5 >> 2);                                         \
        const unsigned _rv = (_kk & ~0xCu) | ((_kk & 4u) << 1) | ((_kk & 8u) >> 1), _cv = ((_sub & 3u) * 32u + (_w5 & 3u) * 8u) * 2u; \
        unsigned _ok = _rk * _ld + _ck, _ov = _rv * _ld + _cv; asm volatile("" : "+v"(_ok), "+v"(_ov));                           \
        __builtin_amdgcn_global_load_lds((const unsigned*)(_k + _ok), (LAS unsigned*)(Kst + (ST) * STG + (wid * 2 + _i) * 1024), 16, 0, 0); \
        __builtin_amdgcn_global_load_lds((const unsigned*)(_v + _ov), (LAS unsigned*)(Vst + (ST) * 2 * STG + (wid * 2 + _i) * 1024), 16, 0, 0); \
        __builtin_amdgcn_global_load_lds((const unsigned*)(_v + 256 + _ov), (LAS unsigned*)(Vst + (ST) * 2 * STG + STG + (wid * 2 + _i) * 1024), 16, 0, 0); } } while (0)
#define WAITV(n) asm volatile("s_waitcnt vmcnt(" #n ")" ::: "memory")
#define BAR() do { asm volatile("s_waitcnt lgkmcnt(0)" ::: "memory"); __builtin_amdgcn_s_barrier(); asm volatile("" ::: "memory"); SBAR(); } while (0)
    const int NT = a.n0 + a.n1;
    ISSUEB(0, 0);
    int st = 0;
#pragma unroll 1
    for (int j = 0; j < NT; ++j) {
        const int stn = (st == 2) ? 0 : st + 1;
        if (j + 1 < NT) { ISSUEB(j + 1, stn); WAITV(6); } else WAITV(0);
        BAR();
        f32x16 p0, p1; float mn, alpha; bf16x8 pa0, pa1, pa2, pa3;
        qkt(p0, p1, Kst + st * STG, qr, r32, hi); SBAR();
        partialSM(p0, p1, m_reg, mn, alpha);
        finishSM(p0, p1, alpha, l_reg, pa0, pa1, pa2, pa3); SBAR();
        if (__any(alpha < 1.f)) { if (hi == 0) al_l[r32] = alpha; asm volatile("s_waitcnt lgkmcnt(0)" ::: "memory");
#pragma unroll
            for (int d = 0; d < 8; ++d)
#pragma unroll
                for (int r = 0; r < 16; ++r) o[d][r] *= al_l[crow(r, hi)]; }
        SBAR();
        const int vb = vb0 + st * 2 * STG;
        pv_pipe<2>(o, vb, pa0, pa1, pa2, pa3);
        st = stn;
    }
    if (hi == 0) li_l[r32] = l_reg;
    BAR();
    {
        int wu = wid; unsigned ln = (unsigned)lane;
        asm volatile("" : "+s"(wu), "+v"(ln));
        char* Ow = (char*)(a.O + (size_t)(wu * 32) * a.ldo); const unsigned ldo2 = (unsigned)a.ldo * 2u;
        LAS unsigned char* img = lds + (unsigned)wu * 16384u;
        const unsigned wb = (ln >> 5) * 4u * 512u + (ln & 31u) * 2u;
#pragma unroll
        for (int r = 0; r < 16; ++r) { const float rli = __builtin_amdgcn_rcpf(li_l[crow(r, hi)]); const unsigned ro = wb + (unsigned)((r & 3) + 8 * (r >> 2)) * 512u;
#pragma unroll
            for (int d = 0; d < 8; ++d) *(LAS bf16_t*)(img + ro + d * 64) = (bf16_t)(cvtpk(o[d][r] * rli, 0.f) & 0xffffu); }
        asm volatile("s_waitcnt lgkmcnt(0)" ::: "memory");
        if (!a.fuse) {
#pragma unroll
            for (int i = 0; i < 16; ++i) { const unsigned c = (unsigned)i * 64u + ln; const unsigned row = c >> 5, ch = (c & 31u) * 16u;
                *(u32x4*)(Ow + row * ldo2 + ch) = *(const LAS u32x4*)(img + row * 512u + ch); }
        } else {
            const char* Gw = (const char*)(a.Gp + (size_t)(wu * 32) * a.ldg); const unsigned ldg2 = (unsigned)a.ldg * 2u;
            const float lam = a.lam; const unsigned cc = (ln & 31u) * 8u;
            const f32x4 sb0 = *(const f32x4*)(a.subln + cc), sb1 = *(const f32x4*)(a.subln + cc + 4);
#pragma unroll 1
            for (int i0 = 0; i0 < 16; i0 += 8) {
                u32x4 w1[8], wg[8];
#pragma unroll
                for (int u = 0; u < 8; ++u) { const unsigned c = (unsigned)(i0 + u) * 64u + ln; const unsigned row = c >> 5, ch = (c & 31u) * 16u;
                    w1[u] = *(const u32x4*)(Ow + row * ldo2 + ch); wg[u] = *(const u32x4*)(Gw + row * ldg2 + ch); }
#pragma unroll
                for (int u = 0; u < 8; ++u) { const unsigned c = (unsigned)(i0 + u) * 64u + ln; const unsigned row = c >> 5, ch = (c & 31u) * 16u;
                    const u32x4 w2 = *(const LAS u32x4*)(img + row * 512u + ch);
                    float d[8] = {bf_lo(w1[u].x) - lam * bf_lo(w2.x), bf_hi(w1[u].x) - lam * bf_hi(w2.x), bf_lo(w1[u].y) - lam * bf_lo(w2.y), bf_hi(w1[u].y) - lam * bf_hi(w2.y),
                                  bf_lo(w1[u].z) - lam * bf_lo(w2.z), bf_hi(w1[u].z) - lam * bf_hi(w2.z), bf_lo(w1[u].w) - lam * bf_lo(w2.w), bf_hi(w1[u].w) - lam * bf_hi(w2.w)};
                    const float g[8] = {bf_lo(wg[u].x), bf_hi(wg[u].x), bf_lo(wg[u].y), bf_hi(wg[u].y), bf_lo(wg[u].z), bf_hi(wg[u].z), bf_lo(wg[u].w), bf_hi(wg[u].w)};
                    float ss = 0;
#pragma unroll
                    for (int q = 0; q < 8; ++q) ss += d[q] * d[q];
                    ss += shx(ss, 16, (int)ln); ss += shx(ss, 8, (int)ln); ss += shx(ss, 4, (int)ln); ss += shx(ss, 2, (int)ln); ss += shx(ss, 1, (int)ln);
                    const float rs = rsqrtf(ss * (1.f / 256.f) + 1e-6f) * (1.f - LINIT);
#pragma unroll
                    for (int q = 0; q < 8; ++q) d[q] = d[q] * rs * (q < 4 ? sb0[q & 3] : sb1[q & 3]) * silu_f(g[q]);
                    u32x4 wo; wo.x = cvtpk(d[0], d[1]); wo.y = cvtpk(d[2], d[3]); wo.z = cvtpk(d[4], d[5]); wo.w = cvtpk(d[6], d[7]);
                    *(u32x4*)(Ow + row * ldo2 + ch) = wo; }
            }
        }
    }
    BAR();
#undef ISSUEB
#undef WAITV
#undef BAR
}

DI void cvt_array(const float* src, bf16_t* dst, long n, int bid, int G, int tid) {
    for (long i = ((long)bid * NTHREADS + tid) * 8; i < n; i += (long)G * NTHREADS * 8) {
        const f32x4 a = *(const f32x4*)(src + i), b = *(const f32x4*)(src + i + 4);
        u32x4 w; w.x = cvtpk(a[0], a[1]); w.y = cvtpk(a[2], a[3]); w.z = cvtpk(b[0], b[1]); w.w = cvtpk(b[2], b[3]);
        *(u32x4*)(dst + i) = w;
    }
}

DI void cvt_array_perm(const float* src, bf16_t* dst, long n, int bid, int G, int tid) {
    for (long i = ((long)bid * NTHREADS + tid) * 8; i < n; i += (long)G * NTHREADS * 8) {
        const long vb = i & ~127L; const int L = (int)(i & 127) >> 3, ax = L >> 3, f0 = (L & 7) * 4;
        const f32x4 a = *(const f32x4*)(src + vb + 64 * ax + f0), b = *(const f32x4*)(src + vb + 64 * ax + 32 + f0);
        u32x4 w; w.x = cvtpk(a[0], b[0]); w.y = cvtpk(a[1], b[1]); w.z = cvtpk(a[2], b[2]); w.w = cvtpk(a[3], b[3]);
        *(u32x4*)(dst + i) = w;
    }
}

DI void phase0(const Params& p, char* lds) {
    int tid_ = threadIdx.x; asm volatile("" : "+v"(tid_));
    const int tid = tid_, G = gridDim.x, bid = blockIdx.x;
    unsigned char* ws = p.ws;
    float* T = (float*)lds;
    for (int it = bid; it < 17408; it += G) {
        const int ct = it >> 5, kt = it & 31;
        const float* src; bf16_t* dst; int N, n0; int qklim = 0;
        if (ct < 160) { const int jj = ct / 80; N = 5120; qklim = 2560; n0 = (ct % 80) * 64; src = p.in[16] + (size_t)jj * 2048 * 5120; dst = (bf16_t*)(ws + WS_WTA) + (size_t)jj * 5120 * 2048; }
        else if (ct < 288) { N = 8192; qklim = 4096; n0 = (ct - 160) * 64; src = p.in[18]; dst = (bf16_t*)(ws + WS_WTB); }
        else if (ct < 416) { N = 8192; qklim = 4096; n0 = (ct - 288) * 64; src = p.in[21]; dst = (bf16_t*)(ws + WS_WTC); }
        else { const int jj = (ct - 416) >> 5; N = 2048; n0 = ((ct - 416) & 31) * 64; src = p.in[13] + (size_t)jj * 2048 * 2048; dst = (bf16_t*)(ws + WS_WTO) + (size_t)jj * 2048 * 2048; }
        const int k0 = kt * 64;
        __syncthreads();
#pragma unroll
        for (int i = 0; i < 2; ++i) { const int k = (tid >> 4) + 32 * i, n4 = (tid & 15) * 4;
            const f32x4 v = *(const f32x4*)(src + (size_t)(k0 + k) * N + n0 + n4);
            T[k * 65 + n4 + 0] = v[0]; T[k * 65 + n4 + 1] = v[1]; T[k * 65 + n4 + 2] = v[2]; T[k * 65 + n4 + 3] = v[3]; }
        __syncthreads();
        { const int n = tid >> 3, k8 = (tid & 7) * 8; u32x4 w;
          w.x = cvtpk(T[(k8 + 0) * 65 + n], T[(k8 + 1) * 65 + n]); w.y = cvtpk(T[(k8 + 2) * 65 + n], T[(k8 + 3) * 65 + n]);
          w.z = cvtpk(T[(k8 + 4) * 65 + n], T[(k8 + 5) * 65 + n]); w.w = cvtpk(T[(k8 + 6) * 65 + n], T[(k8 + 7) * 65 + n]);
          int nn = n0 + n; if (nn < qklim) nn = (nn & ~127) + hd_phys(nn & 127);
          *(u32x4*)(dst + (size_t)nn * 2048 + k0 + k8) = w; }
    }
    bf16_t* cb = (bf16_t*)(ws + WS_CACHE);
    cvt_array_perm(p.in[2], cb + C_AK, 2097152, bid, G, tid); cvt_array(p.in[3], cb + C_AV, 2097152, bid, G, tid);
    cvt_array_perm(p.in[4], cb + C_BK, 4194304, bid, G, tid); cvt_array(p.in[5], cb + C_BV, 4194304, bid, G, tid);
    cvt_array_perm(p.in[6], cb + C_CK, 4194304, bid, G, tid); cvt_array(p.in[7], cb + C_CV, 4194304, bid, G, tid);
    float* scl = (float*)lds + 8192;
    float* part = (float*)(ws + WS_PART);
    for (int it = bid; it < 768; it += G) {
        const int l = it / 192, rem = it % 192, cc = rem >> 4, kc = rem & 15;
        __syncthreads();
        for (int e = tid; e < 9 * 128; e += NTHREADS) { const int r = e >> 7, k = e & 127;
            const float cv = (r == 0) ? p.in[9][kc * 128 + k] : p.in[8][(r - 1) * 2048 + kc * 128 + k]; scl[e] = silu_f(cv); }
        __syncthreads();
        const float* W = p.in[11] + ((size_t)l * 2048 + kc * 128) * 6144 + cc * 512 + tid;
        float a0 = 0, a1 = 0, a2 = 0, a3 = 0, a4 = 0, a5 = 0, a6 = 0, a7 = 0, a8 = 0;
#pragma unroll 8
        for (int k = 0; k < 128; ++k) { const float w = W[(size_t)k * 6144];
            a0 += scl[k] * w; a1 += scl[128 + k] * w; a2 += scl[256 + k] * w; a3 += scl[384 + k] * w; a4 += scl[512 + k] * w;
            a5 += scl[640 + k] * w; a6 += scl[768 + k] * w; a7 += scl[896 + k] * w; a8 += scl[1024 + k] * w; }
        float* po = part + ((size_t)(l * 16 + kc) * 9) * 6144 + cc * 512 + tid;
        po[0] = a0; po[6144] = a1; po[2 * 6144] = a2; po[3 * 6144] = a3; po[4 * 6144] = a4; po[5 * 6144] = a5; po[6 * 6144] = a6; po[7 * 6144] = a7; po[8 * 6144] = a8;
    }
    if (bid == G - 1) {
        float* ct = (float*)(ws + WS_ROPE); float* st = ct + 2048;
        for (int e = tid; e < 2048; e += NTHREADS) { const int pos = e >> 5, f = e & 31;
            double inv = 1.0; for (int q = 0; q < f; ++q) inv *= 0.74989420933245582730;
            const float invf = (float)inv; const float angf = (float)pos * invf;
            double x = (double)angf; const double twopi = 6.283185307179586476925;
            const double kq = __builtin_rint(x / twopi); x -= kq * twopi;
            const double x2 = x * x; double sn = x, cs = 1.0, ts = x, tc = 1.0;
            for (int q = 1; q <= 12; ++q) { tc *= -x2 / (double)((2 * q - 1) * (2 * q)); cs += tc; ts *= -x2 / (double)((2 * q) * (2 * q + 1)); sn += ts; }
            ct[e] = (float)cs; st[e] = (float)sn; }
    }
}

DI void ada_reduce(const Params& p) {
    int tid_ = threadIdx.x; asm volatile("" : "+v"(tid_));
    const int tid = tid_, G = gridDim.x, bid = blockIdx.x;
    unsigned char* ws = p.ws;
    const float* part = (const float*)(ws + WS_PART);
    float* modA = (float*)(ws + WS_MODA); float* modB = (float*)(ws + WS_MODB); float* gate = (float*)(ws + WS_GATE);
    for (int e = bid * NTHREADS + tid; e < 4 * 9 * 6144; e += G * NTHREADS) {
        const int j = e % 6144, lr = e / 6144, l = lr / 9, r = lr % 9;
        float m = p.in[12][l * 6144 + j];
#pragma unroll
        for (int kc = 0; kc < 16; ++kc) m += part[((size_t)(l * 16 + kc) * 9 + r) * 6144 + j];
        if (j < 2048) modB[lr * 2048 + j] = m;
        else if (j < 4096) modA[lr * 2048 + j - 2048] = p.in[10][l * 2048 + j - 2048] * (1.f + m);
        else gate[lr * 2048 + j - 4096] = m;
    }
    if (bid == 0 && tid < 64) {
        const float* lam = p.in[19]; float s1 = 0, s2 = 0;
        for (int k = tid; k < 128; k += 64) { s1 += lam[k] * lam[128 + k]; s2 += lam[256 + k] * lam[384 + k]; }
#pragma unroll
        for (int o = 32; o >= 1; o >>= 1) { s1 += shx(s1, o, tid); s2 += shx(s2, o, tid); }
        if (tid == 0) ((float*)(ws + WS_MISC))[0] = expf(s1) - expf(s2) + LINIT;
    }
}

DI void prenorm(const Params& p, int l) {
    int tid_ = threadIdx.x; asm volatile("" : "+v"(tid_));
    const int tid = tid_, G = gridDim.x, bid = blockIdx.x, wid = tid >> 6, lane = tid & 63;
    unsigned char* ws = p.ws; bf16_t* H = (bf16_t*)(ws + WS_H);
    f32x4 v[8], vn[8];
    int t = bid * 8 + wid;
#define PN_SRC(tt) ((l == 0) ? ((tt) < M_CTX ? p.in[0] + (size_t)(tt) * DM : p.in[1] + (size_t)((tt) - M_CTX) * DM) : p.out + (size_t)(tt) * DM)
    if (t < MT) { const float* x = PN_SRC(t);
#pragma unroll
        for (int i = 0; i < 8; ++i) v[i] = *(const f32x4*)(x + i * 256 + lane * 4); }
    for (; t < MT; t += G * 8) {
        const int tn = t + G * 8;
        if (tn < MT) { const float* xn = PN_SRC(tn);
#pragma unroll
            for (int i = 0; i < 8; ++i) vn[i] = *(const f32x4*)(xn + i * 256 + lane * 4); }
        const int r9 = t < M_CTX ? 0 : 1 + ((t - M_CTX) >> 12);
        const float* A = (const float*)(ws + WS_MODA) + (l * 9 + r9) * DM; const float* B = (const float*)(ws + WS_MODB) + (l * 9 + r9) * DM;
        f32x4 am[8], bm[8];
#pragma unroll
        for (int i = 0; i < 8; ++i) { am[i] = *(const f32x4*)(A + i * 256 + lane * 4); bm[i] = *(const f32x4*)(B + i * 256 + lane * 4); }
        float ss = 0;
#pragma unroll
        for (int i = 0; i < 8; ++i) ss += v[i][0] * v[i][0] + v[i][1] * v[i][1] + v[i][2] * v[i][2] + v[i][3] * v[i][3];
#pragma unroll
        for (int o = 32; o >= 1; o >>= 1) ss += shx(ss, o, lane);
        const float rs = rsqrtf(ss * (1.f / 2048.f) + 1e-6f);
#pragma unroll
        for (int i = 0; i < 8; ++i) { const f32x4 y = v[i] * rs * am[i] + bm[i]; u32x2 w; w.x = cvtpk(y[0], y[1]); w.y = cvtpk(y[2], y[3]);
            *(u32x2*)(H + (size_t)t * DM + i * 256 + lane * 4) = w; }
#pragma unroll
        for (int i = 0; i < 8; ++i) v[i] = vn[i];
    }
#undef PN_SRC
}

DI void bpost(const Params& p) {
    int tid_ = threadIdx.x; asm volatile("" : "+v"(tid_));
    const int tid = tid_, G = gridDim.x, bid = blockIdx.x, i = tid & 31, ln = tid & 63;
    unsigned char* ws = p.ws; bf16_t* QK = (bf16_t*)(ws + WS_QKVG); bf16_t* OG = (bf16_t*)(ws + WS_H);
    const float lam = ((const float*)(ws + WS_MISC))[0];
    const f32x4 sb0 = *(const f32x4*)(p.in[20] + i * 8), sb1 = *(const f32x4*)(p.in[20] + i * 8 + 4);
    const int tstep = G * (NTHREADS / 32);
    u32x4 w1[4], w2[4], wg[4], n1[4], n2[4], ng[4];
#define BP_LD(A1, A2, AG, tt, hh0) do { _Pragma("unroll") for (int u = 0; u < 4; ++u) { const int _h = (hh0) + u;                   \
        A1[u] = *(const u32x4*)(OG + (size_t)(tt) * 2048 + _h * 256 + i * 8); A2[u] = *(const u32x4*)(QK + (size_t)(tt) * 8192 + _h * 256 + i * 8); \
        AG[u] = *(const u32x4*)(QK + (size_t)(tt) * 8192 + 6144 + _h * 256 + i * 8); } } while (0)
    int t = (bid * NTHREADS + tid) >> 5;
    if (t < MT) BP_LD(w1, w2, wg, t, 0);
    for (; t < MT; t += tstep) {
#pragma unroll 1
        for (int h0 = 0; h0 < 8; h0 += 4) {
            const int tn = (h0 == 0) ? t : t + tstep, hn = (h0 == 0) ? 4 : 0;
            if (tn < MT) BP_LD(n1, n2, ng, tn, hn);
#pragma unroll
            for (int u = 0; u < 4; ++u) { const int h = h0 + u;
                float d[8] = {bf_lo(w1[u].x) - lam * bf_lo(w2[u].x), bf_hi(w1[u].x) - lam * bf_hi(w2[u].x), bf_lo(w1[u].y) - lam * bf_lo(w2[u].y), bf_hi(w1[u].y) - lam * bf_hi(w2[u].y),
                              bf_lo(w1[u].z) - lam * bf_lo(w2[u].z), bf_hi(w1[u].z) - lam * bf_hi(w2[u].z), bf_lo(w1[u].w) - lam * bf_lo(w2[u].w), bf_hi(w1[u].w) - lam * bf_hi(w2[u].w)};
                const float g[8] = {bf_lo(wg[u].x), bf_hi(wg[u].x), bf_lo(wg[u].y), bf_hi(wg[u].y), bf_lo(wg[u].z), bf_hi(wg[u].z), bf_lo(wg[u].w), bf_hi(wg[u].w)};
                float ss = 0;
#pragma unroll
                for (int q = 0; q < 8; ++q) ss += d[q] * d[q];
                ss += shx(ss, 16, ln); ss += shx(ss, 8, ln); ss += shx(ss, 4, ln); ss += shx(ss, 2, ln); ss += shx(ss, 1, ln);
                const float rs = rsqrtf(ss * (1.f / 256.f) + 1e-6f) * (1.f - LINIT);
#pragma unroll
                for (int q = 0; q < 8; ++q) d[q] = d[q] * rs * (q < 4 ? sb0[q & 3] : sb1[q & 3]) * silu_f(g[q]);
                u32x4 wo; wo.x = cvtpk(d[0], d[1]); wo.y = cvtpk(d[2], d[3]); wo.z = cvtpk(d[4], d[5]); wo.w = cvtpk(d[6], d[7]);
                *(u32x4*)(OG + (size_t)t * 2048 + h * 256 + i * 8) = wo; }
#pragma unroll
            for (int u = 0; u < 4; ++u) { w1[u] = n1[u]; w2[u] = n2[u]; wg[u] = ng[u]; }
        }
    }
#undef BP_LD
}

DI void attn_phase(const Params& p, int kind, int jdx, LAS unsigned char* lds) {
    int tid_ = threadIdx.x; asm volatile("" : "+v"(tid_));
    const int G = gridDim.x, bid = blockIdx.x, tid = tid_;
    unsigned char* ws = p.ws; bf16_t* QK = (bf16_t*)(ws + WS_QKVG); bf16_t* OG = (bf16_t*)(ws + WS_H); const bf16_t* cb = (const bf16_t*)(ws + WS_CACHE);
    LAS float* rpbL = (LAS float*)(lds + RPB_OFF);
    const int nlat = (kind == 1) ? 1024 : 2048, nitems = (kind == 1) ? 1280 : 2560, npass = (kind == 1) ? 2 : 1;
    const long N = (kind == 0) ? 5120 : 8192;
#pragma unroll 1
    for (int it = bid; it < nitems; it += G) {
#pragma unroll 1
        for (int ps = 0; ps < npass; ++ps) {
            AttnArgs a; a.fuse = 0; a.subln = nullptr; a.lam = 0.f; a.ldq = N; a.ldg = N; a.ldo = 2048; a.has_sink = 0; a.sinkl2 = 0.f; a.out_mode = 0; a.r0 = 0; a.rbase = 0; a.mode = 0; a.qpos0 = 0; a.s1_start = 0; a.s1_max = 4032; a.n0 = 4; a.ld1 = N;
            __syncthreads();
            const bool lat = it < nlat;
            if (kind == 0) {
                int b, h; long row0;
                if (lat) { b = it >> 8; const int rem = it & 255, qb = rem >> 4; h = (rem & 3) * 4 + ((rem >> 2) & 1) * 2 + ((rem >> 3) & 1); row0 = M_CTX + b * 4096 + qb * 256;
                    a.K0 = cb + C_AK + ((size_t)(b * 2 + jdx) * 256) * 512 + (h >> 2) * 128; a.V0 = a.K0 + (C_AV - C_AK); a.ld0 = 512;
                    a.K1 = QK + (long)(M_CTX + b * 4096) * N + 2048 + (h >> 2) * 128; a.n1 = 8; a.s1_start = qb * 256 - 128; a.mode = 1; a.qpos0 = qb * 256; }
                else { const int id = it - 2048; b = id >> 4; h = (id & 3) * 4 + ((id >> 2) & 1) * 2 + ((id >> 3) & 1); row0 = b * 256;
                    a.K0 = QK + row0 * N + 2048 + (h >> 2) * 128; a.V0 = a.K0 + 512; a.ld0 = N; a.K1 = a.K0; a.n1 = 0; }
                a.V1 = a.K1 + 512; a.has_sink = 1; a.sinkl2 = p.in[17][jdx * 16 + h] * LOG2E;
                a.Q = QK + row0 * N + h * 128; a.O = OG + row0 * 2048 + h * 128; a.Gp = QK + row0 * N + 3072 + h * 128;
            } else if (kind == 1) {
                const int m = ps; int b, h; long row0, krow0;
                if (lat) { b = it >> 7; const int rem = it & 127, qb = rem >> 3; h = rem & 7; row0 = M_CTX + b * 4096 + qb * 256; krow0 = M_CTX + b * 4096; a.n1 = 64;
                    a.K0 = cb + C_BK + (size_t)b * 256 * 2048 + h * 256 + m * 128; a.V0 = cb + C_BV + (size_t)b * 256 * 2048 + h * 256; a.ld0 = 2048; }
                else { const int id = it - 1024; b = id >> 3; h = id & 7; row0 = b * 256; krow0 = row0; a.n1 = 0;
                    a.K0 = QK + row0 * N + 2048 + h * 256 + m * 128; a.V0 = QK + row0 * N + 4096 + h * 256; a.ld0 = N; }
                a.Q = QK + row0 * N + h * 256 + m * 128;
                a.K1 = QK + krow0 * N + 2048 + h * 256 + m * 128; a.V1 = QK + krow0 * N + 4096 + h * 256;
                a.out_mode = 1; a.Gp = QK + row0 * N + 6144 + h * 256; a.O = OG + row0 * 2048 + h * 256;
                a.fuse = m; a.subln = p.in[20]; a.lam = ((const float*)(ws + WS_MISC))[0];
                attn_body_b(a, lds);
                continue;
            } else {
                int b, h; long row0;
                if (lat) { b = it >> 8; const int rem = it & 255, qb = rem >> 4; h = rem & 15; row0 = M_CTX + b * 4096 + qb * 256;
                    for (int e = tid; e < 465; e += NTHREADS) rpbL[e] = p.in[22][h * 465 + e] * (1.f / SCALE);
                    a.K0 = cb + C_CK + (size_t)b * 256 * 2048 + h * 128; a.V0 = a.K0 + (C_CV - C_CK); a.ld0 = 2048;
                    a.K1 = QK + (long)(M_CTX + b * 4096) * N + 2048 + h * 128; a.n1 = 12;
                    a.r0 = qb * 4; a.rbase = min(max(qb * 4 - 4, 0), 52); a.s1_start = a.rbase * 64; a.mode = 2; }
                else { const int id = it - 2048; b = id >> 4; h = id & 15; row0 = b * 256;
                    a.K0 = QK + row0 * N + 2048 + h * 128; a.V0 = a.K0 + 2048; a.ld0 = N; a.K1 = a.K0; a.n1 = 0; }
                a.V1 = a.K1 + 2048;
                a.Q = QK + row0 * N + h * 128; a.O = OG + row0 * 2048 + h * 128; a.Gp = QK + row0 * N + 6144 + h * 128;
            }
            attn_body(a, lds);
        }
    }
}

#define XB_TMO      128
#define XB_XCNT(j)  (256  + 64 * (j))
#define XB_XSUB(j)  (1280 + 64 * (j))
#define XB_XGEN(j)  (2304 + 64 * (j))
#define XB_TOP      3328
#define XB_TOPGEN   3392
#define XCD_BAR_WORDS 3456
#define XB_SPIN_CAP (1u << 18)
DI unsigned xb_ld(unsigned* p)              { return __hip_atomic_load(p, __ATOMIC_RELAXED, __HIP_MEMORY_SCOPE_AGENT); }
DI unsigned xb_add(unsigned* p, unsigned v) { return __hip_atomic_fetch_add(p, v, __ATOMIC_RELAXED, __HIP_MEMORY_SCOPE_AGENT); }
DI unsigned xb_xcc_id() { return (unsigned)__builtin_amdgcn_s_getreg((3 << 11) | 20) & 0xFu; }
#define XB_SPIN(cond, bar) do { unsigned _sp = 0; while (cond) { __builtin_amdgcn_s_sleep(1); \
    if ((++_sp & 255u) == 0u) { if (xb_ld(&(bar)[XB_TMO])) break; if (_sp > XB_SPIN_CAP) { atomicAdd(&(bar)[XB_TMO], 1u); break; } } } } while (0)
DI void xcd_barrier_complete(unsigned* bar, unsigned x, unsigned& nloc, unsigned& nx) {
    const unsigned G = gridDim.x;
    unsigned sum, cnt, mine, sp = 0u;
    for (;;) {
        sum = 0u; cnt = 0u; mine = 0u;
#pragma unroll
        for (unsigned j = 0; j < 16; ++j) { const unsigned c = xb_ld(&bar[XB_XCNT(j)]); sum += c; cnt += (c > 0u) ? 1u : 0u; mine = (j == x) ? c : mine; }
        if (sum == G) break;
        __builtin_amdgcn_s_sleep(1);
        if ((++sp & 255u) == 0u) { if (xb_ld(&bar[XB_TMO])) break; if (sp > XB_SPIN_CAP) { atomicAdd(&bar[XB_TMO], 1u); break; } }
    }
    nloc = mine > 0u ? mine : 1u; nx = cnt > 0u ? cnt : 1u;
}
DI void xcd_barrier(unsigned* bar, volatile LAS unsigned* st) {
    asm volatile("s_waitcnt vmcnt(0)" ::: "memory");
    __syncthreads();
    if (threadIdx.x == 0) {
        const unsigned x = xb_xcc_id();
        __builtin_amdgcn_s_waitcnt(0);
        unsigned nloc = st[0], nx = st[1];
        if (nloc == 0u) { xcd_barrier_complete(bar, x, nloc, nx); st[0] = nloc; st[1] = nx; }
        const unsigned old = xb_add(&bar[XB_XSUB(x)], 1u);
        const unsigned gen = old / nloc;
        if (old + 1u == (gen + 1u) * nloc) {
            __builtin_amdgcn_fence(__ATOMIC_RELEASE, "agent");
            asm volatile("s_waitcnt vmcnt(0)" ::: "memory");
            const unsigned og = xb_add(&bar[XB_TOP], 1u);
            const unsigned tg = og / nx;
            if (og + 1u == (tg + 1u) * nx) xb_add(&bar[XB_TOPGEN], 1u);
            else XB_SPIN(xb_ld(&bar[XB_TOPGEN]) == tg, bar);
            __builtin_amdgcn_fence(__ATOMIC_ACQUIRE, "agent");
            xb_add(&bar[XB_XGEN(x)], 1u);
            asm volatile("s_waitcnt vmcnt(0)" ::: "memory");
        } else {
            XB_SPIN(xb_ld(&bar[XB_XGEN(x)]) == gen, bar);
            __builtin_amdgcn_fence(__ATOMIC_ACQUIRE, "agent");
            asm volatile("s_waitcnt vmcnt(0)" ::: "memory");
        }
    }
    __syncthreads();
}

__global__ void __launch_bounds__(NTHREADS, 2) fwd_megakernel(Params p) {
    extern __shared__ __attribute__((aligned(16))) unsigned char shm[];
    cg::grid_group grid = cg::this_grid();
    unsigned char* ws = p.ws;
    const int G = gridDim.x;
    volatile LAS unsigned* xst = (volatile LAS unsigned*)((LAS unsigned char*)shm + XB_ST_OFF);
    unsigned* xbar = (unsigned*)(ws + WS_BAR);
    if (threadIdx.x < 2) xst[threadIdx.x] = 0u;
    __syncthreads();
    if (blockIdx.x == 0) for (int i = threadIdx.x; i < XCD_BAR_WORDS; i += NTHREADS) xbar[i] = 0u;
    phase0(p, (char*)shm);
    grid.sync();
    if (threadIdx.x == 0) (void)xb_add(&xbar[XB_XCNT(xb_xcc_id())], 1u);
    ada_reduce(p);
    xcd_barrier(xbar, xst);
#pragma unroll 1
    for (int l = 0; l < 4; ++l) {
        const int kind = l % 3, jdx = l / 3;
        prenorm(p, l);
        xcd_barrier(xbar, xst);
        {
            const bf16_t* Wt = (kind == 0) ? (const bf16_t*)(ws + WS_WTA) + (size_t)jdx * 5120 * 2048 : (kind == 1) ? (const bf16_t*)(ws + WS_WTB) : (const bf16_t*)(ws + WS_WTC);
            const int N = (kind == 0) ? 5120 : 8192;
            pg8::Gemm g{(const bf16_t*)(ws + WS_H), Wt, MT, N, DM}; pg8::StaticOrder S; S.init(MT, N, G, (int)blockIdx.x);
            pg8::EpiQKVG E{(bf16_t*)(ws + WS_QKVG), N, (kind == 0) ? 10 : 16, (kind == 0) ? 10 : 16, (kind == 0) ? 12 : 24, p.in[14] + l * 128, p.in[15] + l * 128,
                           (const float*)(ws + WS_ROPE), (kind != 2) ? 1 : 0, p.out + (kind == 0 ? O_AK : kind == 1 ? O_BK : O_CK), p.out + (kind == 0 ? O_AV : kind == 1 ? O_BV : O_CV), (kind == 0) ? 1 : 0, jdx};
            pg8::gemm_phase<pg8::EpiQKVG, pg8::StaticOrder>((LAS unsigned char*)shm, g, S, E);
        }
        xcd_barrier(xbar, xst);
        attn_phase(p, kind, jdx, (LAS unsigned char*)shm);
        xcd_barrier(xbar, xst);
        {
            pg8::Gemm g{(const bf16_t*)(ws + WS_H), (const bf16_t*)(ws + WS_WTO) + (size_t)l * 2048 * 2048, MT, DM, DM}; pg8::StaticOrder S; S.init(MT, DM, G, (int)blockIdx.x);
            pg8::EpiOut E{l == 0 ? p.in[0] : p.out, l == 0 ? p.in[1] : p.out + (size_t)M_CTX * DM, p.out, (const float*)(ws + WS_GATE) + (size_t)l * 9 * DM};
            pg8::gemm_phase<pg8::EpiOut, pg8::StaticOrder>((LAS unsigned char*)shm, g, S, E);
        }
        if (l < 3) xcd_barrier(xbar, xst);
    }
}

extern "C" void kernel_launch(void* const* d_in, const int* in_sizes, int n_in, void* d_out, int out_size, void* d_ws, size_t ws_size, hipStream_t stream) {
    static int grid_blocks = 0;
    if (grid_blocks == 0) {
        if (n_in != 23 || ws_size < WS_END) { fprintf(stderr, "kernel_launch: unexpected n_in %d or ws_size %zu (need %zu)\n", n_in, ws_size, (size_t)WS_END); grid_blocks = -1; return; }
        int dev = 0, cus = 0, per_cu = 0;
        hipGetDevice(&dev);
        hipDeviceGetAttribute(&cus, hipDeviceAttributeMultiprocessorCount, dev);
        if (hipFuncSetAttribute((const void*)fwd_megakernel, hipFuncAttributeMaxDynamicSharedMemorySize, LDS_BYTES) != hipSuccess) { fprintf(stderr, "kernel_launch: hipFuncSetAttribute failed\n"); grid_blocks = -1; return; }
        hipOccupancyMaxActiveBlocksPerMultiprocessor(&per_cu, (const void*)fwd_megakernel, NTHREADS, LDS_BYTES);
        if (per_cu < 1) { fprintf(stderr, "kernel_launch: occupancy query says %d blocks per CU\n", per_cu); per_cu = 1; }
        (void)hipGetLastError();
        grid_blocks = cus * 1;
    }
    if (grid_blocks < 0) return;
    Params p{};
    for (int i = 0; i < 23; ++i) p.in[i] = (const float*)d_in[i];
    p.out = (float*)d_out; p.ws = (unsigned char*)d_ws;
    void* args[] = {&p};
    hipError_t e = hipLaunchCooperativeKernel((const void*)fwd_megakernel, dim3(grid_blocks), dim3(NTHREADS), args, LDS_BYTES, stream);
    if (e != hipSuccess) fprintf(stderr, "cooperative launch failed: %s (grid %d)\n", hipGetErrorString(e), grid_blocks);
}
```

```cpp
#include <hip/hip_runtime.h>
#include <hip/hip_cooperative_groups.h>
#include <cstdio>
#include <cstdint>
namespace cg = cooperative_groups;

#define DI __device__ __forceinline__
#define LAS __attribute__((address_space(3)))
typedef unsigned short bf16_t;
typedef short bf16x8 __attribute__((ext_vector_type(8)));
typedef short s16x4 __attribute__((ext_vector_type(4)));
typedef float f32x4 __attribute__((ext_vector_type(4)));
typedef float f32x16 __attribute__((ext_vector_type(16)));
typedef unsigned u32x4 __attribute__((ext_vector_type(4)));
typedef unsigned u32x2 __attribute__((ext_vector_type(2)));

constexpr int DM = 2048, M_CTX = 8192, M_LAT = 32768, MT = 40960;
constexpr float SCALE = 0.088388347648318440f;
constexpr float LOG2E = 1.4426950408889634f;
constexpr float LINIT = 0.35550906759f;
constexpr int NTHREADS = 512;
constexpr int XB_ST_OFF = 149504;
constexpr int LDS_BYTES = 149504 + 16;

constexpr size_t O_YP = 0, O_YS = 16777216, O_AK = 83886080, O_AV = 92274688, O_BK = 100663296, O_BV = 117440512, O_CK = 134217728, O_CV = 150994944;

constexpr size_t WS_WTA = 0;
constexpr size_t WS_WTB = WS_WTA + 41943040;
constexpr size_t WS_WTC = WS_WTB + 33554432;
constexpr size_t WS_WTO = WS_WTC + 33554432;
constexpr size_t WS_CACHE = WS_WTO + 33554432;
constexpr size_t WS_PART = WS_CACHE + 41943040;
constexpr size_t WS_MODA = WS_PART + 14155776;
constexpr size_t WS_MODB = WS_MODA + 294912;
constexpr size_t WS_GATE = WS_MODB + 294912;
constexpr size_t WS_ROPE = WS_GATE + 294912;
constexpr size_t WS_MISC = WS_ROPE + 16384;
constexpr size_t WS_H = WS_MISC + 4096;
constexpr size_t WS_QKVG = WS_H + 167772160;
constexpr size_t WS_BAR = WS_QKVG + 671088640;
constexpr size_t WS_END = WS_QKVG + 671088640 + 65536;
constexpr size_t C_AK = 0, C_AV = 2097152, C_BK = 4194304, C_BV = 8388608, C_CK = 12582912, C_CV = 16777216;

struct Params { const float* in[23]; float* out; unsigned char* ws; };

DI unsigned cvtpk(float lo, float hi) { unsigned r; asm volatile("v_cvt_pk_bf16_f32 %0, %1, %2" : "=v"(r) : "v"(lo), "v"(hi)); return r; }
DI float bf_lo(unsigned w) { return __uint_as_float(w << 16); }
DI float bf_hi(unsigned w) { return __uint_as_float(w & 0xffff0000u); }
DI float bf2f(bf16_t x) { return __uint_as_float((unsigned)x << 16); }
DI float silu_f(float g) { return g / (1.f + __expf(-g)); }
DI float shx(float v, int m, int lane) { return __int_as_float(__builtin_amdgcn_ds_bpermute((lane ^ m) << 2, __float_as_int(v))); }

DI int hd_phys(int e) { const int a = e >> 6, half = (e >> 5) & 1, f = e & 31, pi = 32 * a + f; return 8 * (pi >> 2) + 2 * (pi & 3) + half; }

namespace pg8 {
constexpr int BM = 256, BK = 64, HALF = 128, HTB = HALF * BK * 2, STAGE_BYTES = 8 * HTB, NXCD = 8, WGM = 8;
DI int lds_byte(int r, int c) { const int st = (r >> 4) * 2 + (c >> 5), rr = r & 15, cc = c & 31, ob = rr * 64 + cc * 2; return st * 1024 + (ob ^ (((ob >> 9) & 1) << 5)); }
DI void stage_rc(int b, int& R, int& C) { const int st = b / 1024, sb = b % 1024, swz = sb ^ (((sb >> 9) & 1) << 5); R = (st >> 1) * 16 + swz / 64; C = (st & 1) * 32 + (swz % 64) / 2; }
DI int perm32(int rho) { const int n = rho >> 4, i = rho & 15; return 8 * (i >> 2) + 4 * n + (i & 3); }
struct Unit { int pm, pn; };
struct Gemm { const bf16_t* A; const bf16_t* Bt; int M, N, K; };
struct StaticOrder {
    int nM, nN, nwg, G, c;
    DI void init(int M, int N, int G_, int c_) { nM = M / BM; nN = N / BM; nwg = nM * nN; G = G_; c = c_; }
    DI bool next(int i, Unit& u) const {
        const long L = (long)i * G + c; if (L >= nwg) return false;
        int wgid = (int)L; { const int q = nwg / NXCD, r = nwg % NXCD, xcd = wgid % NXCD, off = wgid / NXCD; wgid = (xcd < r ? xcd * (q + 1) : r * (q + 1) + (xcd - r) * q) + off; }
        const int nig = WGM * nN, gid = wgid / nig, fm = gid * WGM, gsz = (nM - fm) < WGM ? (nM - fm) : WGM;
        u.pm = fm + ((wgid % nig) % gsz); u.pn = (wgid % nig) / gsz; return true;
    }
};

struct EpiQKVG {
    static constexpr bool PERM = true;
    bf16_t* O; int ldc; int nqk, nv0, nv1; const float* qg; const float* kg; const float* cosT; int do_rope; float* kout; float* vout; int kindA, jdx;
    DI void operator()(const f32x4 (&acc)[2][2][4][2], const Unit& u, int wr, int wc, int fr, int fq, LAS unsigned char* lds) const {
        { int ln_; asm volatile("v_mbcnt_lo_u32_b32 %0, -1, 0\n\tv_mbcnt_hi_u32_b32 %0, -1, %0" : "=v"(ln_)); fr = ln_ & 15; fq = ln_ >> 4; }
        const int row0 = u.pm * BM + wr * 64 + fr; const int col0 = u.pn * BM + wc * 32 + 8 * fq;
        const bool ctx = u.pm < 32;
        if (u.pn >= nqk) {
            const bool vt = ctx && u.pn >= nv0 && u.pn < nv1;
#pragma unroll
            for (int ai = 0; ai < 2; ++ai)
#pragma unroll
                for (int m = 0; m < 4; ++m) { const int row = row0 + ai * HALF + m * 16; bf16_t* rowp = O + (size_t)row * ldc + col0;
#pragma unroll
                    for (int bj = 0; bj < 2; ++bj) { const f32x4 v0 = acc[ai][bj][m][0], v1 = acc[ai][bj][m][1];
                        u32x4 w; w.x = cvtpk(v0[0], v0[1]); w.y = cvtpk(v0[2], v0[3]); w.z = cvtpk(v1[0], v1[1]); w.w = cvtpk(v1[2], v1[3]);
                        *(u32x4*)(rowp + bj * HALF) = w;
                        if (vt) { const int vc = col0 + bj * HALF - nv0 * BM;
                            float* d = kindA ? vout + ((size_t)((u.pm * 2 + jdx) * 256 + (row & 255))) * 512 + vc : vout + (size_t)row * 2048 + vc;
                            *(f32x4*)d = v0; *(f32x4*)(d + 4) = v1; } } }
            return;
        }
        const int L = wc * 4 + fq, ax = L >> 3, f0 = (L & 7) * 4;
        const float* gs = (u.pn < 8) ? qg : kg;
        const f32x4 g0 = *(const f32x4*)(gs + 64 * ax + f0), g1 = *(const f32x4*)(gs + 64 * ax + 32 + f0);
        LAS float* part = (LAS float*)(lds + 131072);
#pragma unroll
        for (int ai = 0; ai < 2; ++ai)
#pragma unroll
            for (int m = 0; m < 4; ++m)
#pragma unroll
                for (int bj = 0; bj < 2; ++bj) { const f32x4 x0 = acc[ai][bj][m][0], x1 = acc[ai][bj][m][1];
                    float ss = x0[0] * x0[0] + x0[1] * x0[1] + x0[2] * x0[2] + x0[3] * x0[3] + x1[0] * x1[0] + x1[1] * x1[1] + x1[2] * x1[2] + x1[3] * x1[3];
                    { auto r16 = __builtin_amdgcn_permlane16_swap(__float_as_uint(ss), __float_as_uint(ss), false, false); ss = __uint_as_float(r16[0]) + __uint_as_float(r16[1]);
                      auto r32_ = __builtin_amdgcn_permlane32_swap(__float_as_uint(ss), __float_as_uint(ss), false, false); ss = __uint_as_float(r32_[0]) + __uint_as_float(r32_[1]); }
                    if (fq == 0) part[(((((wr * 2 + ai) * 4 + m) * 16 + fr) * 2 + bj) << 2) + wc] = ss; }
        asm volatile("s_waitcnt lgkmcnt(0)" ::: "memory"); __builtin_amdgcn_s_barrier(); asm volatile("" ::: "memory");
        const bool rope = (!ctx) && do_rope; const bool kt = ctx && u.pn >= 8;
        f32x4 cs[2][4], sn[2][4];
#pragma unroll
        for (int ai = 0; ai < 2; ++ai)
#pragma unroll
            for (int m = 0; m < 4; ++m) { cs[ai][m] = (f32x4){1.f, 1.f, 1.f, 1.f}; sn[ai][m] = (f32x4){0.f, 0.f, 0.f, 0.f};
                if (rope) { const int row = row0 + ai * HALF + m * 16; const int n = (row - M_CTX) & 4095; const int pos = ax ? (n & 63) : (n >> 6);
                    cs[ai][m] = *(const f32x4*)(cosT + pos * 32 + f0); sn[ai][m] = *(const f32x4*)(cosT + 2048 + pos * 32 + f0); } }
#pragma unroll
        for (int ai = 0; ai < 2; ++ai)
#pragma unroll
            for (int m = 0; m < 4; ++m) { const int row = row0 + ai * HALF + m * 16; bf16_t* rowp = O + (size_t)row * ldc + col0;
                const f32x4 c4 = cs[ai][m], s4 = sn[ai][m];
#pragma unroll
                for (int bj = 0; bj < 2; ++bj) { const f32x4 x0 = acc[ai][bj][m][0], x1 = acc[ai][bj][m][1];
                    const f32x4 pt = *(const LAS f32x4*)(part + (((((wr * 2 + ai) * 4 + m) * 16 + fr) * 2 + bj) << 2));
                    const float rs = rsqrtf((pt[0] + pt[1] + pt[2] + pt[3]) * (1.f / 128.f) + 1e-6f);
                    f32x4 h0 = {x0[0] * rs * g0[0], x0[2] * rs * g0[1], x1[0] * rs * g0[2], x1[2] * rs * g0[3]};
                    f32x4 h1 = {x0[1] * rs * g1[0], x0[3] * rs * g1[1], x1[1] * rs * g1[2], x1[3] * rs * g1[3]};
                    const f32x4 r0 = h0 * c4 - h1 * s4, r1 = h1 * c4 + h0 * s4;
                    u32x4 w; w.x = cvtpk(r0[0], r1[0]); w.y = cvtpk(r0[1], r1[1]); w.z = cvtpk(r0[2], r1[2]); w.w = cvtpk(r0[3], r1[3]);
                    *(u32x4*)(rowp + bj * HALF) = w;
                    if (kt) { const int hk = (u.pn - 8) * 2 + bj;
                        float* d = (kindA ? kout + ((size_t)((u.pm * 2 + jdx) * 256 + (row & 255))) * 512 : kout + (size_t)row * 2048) + hk * 128 + 64 * ax + f0;
                        *(f32x4*)d = r0; *(f32x4*)(d + 32) = r1; } } }
    }
};
struct EpiOut {
    static constexpr bool PERM = false;
    const float* xin_ctx; const float* xin_lat; float* out; const float* gate;
    DI void operator()(const f32x4 (&acc)[2][2][4][2], const Unit& u, int wr, int wc, int fr, int fq, LAS unsigned char*) const {
        const int row0 = u.pm * BM + wr * 64 + fr, col0 = u.pn * BM + wc * 32 + 4 * fq;
        const bool ctx = u.pm < 32; const int r9 = ctx ? 0 : 1 + ((u.pm - 32) >> 4);
        const float* xb = ctx ? xin_ctx : xin_lat; const int rsub = ctx ? 0 : M_CTX;
        f32x4 gv[2][2];
#pragma unroll
        for (int bj = 0; bj < 2; ++bj)
#pragma unroll
            for (int n = 0; n < 2; ++n) gv[bj][n] = *(const f32x4*)(gate + r9 * DM + col0 + bj * HALF + n * 16);
        f32x4 xr_[3][2][2];
#define EPO_LD(g, slot) do { const int _row = row0 + ((g) >> 2) * HALF + ((g) & 3) * 16; const float* _xr = xb + (size_t)(_row - rsub) * DM + col0;      \
        _Pragma("unroll") for (int bj = 0; bj < 2; ++bj) _Pragma("unroll") for (int n = 0; n < 2; ++n) xr_[slot][bj][n] = *(const f32x4*)(_xr + bj * HALF + n * 16); } while (0)
        EPO_LD(0, 0); EPO_LD(1, 1); EPO_LD(2, 2);
#pragma unroll
        for (int g = 0; g < 8; ++g) { const int ai = g >> 2, m = g & 3, slot = g % 3; const int row = row0 + ai * HALF + m * 16; float* orow = out + (size_t)row * DM + col0;
#pragma unroll
            for (int bj = 0; bj < 2; ++bj)
#pragma unroll
                for (int n = 0; n < 2; ++n) *(f32x4*)(orow + bj * HALF + n * 16) = xr_[slot][bj][n] + gv[bj][n] * acc[ai][bj][m][n];
            __builtin_amdgcn_sched_barrier(0);
            if (g + 3 < 8) { if (slot == 0) EPO_LD(g + 3, 0); else if (slot == 1) EPO_LD(g + 3, 1); else EPO_LD(g + 3, 2); }
            __builtin_amdgcn_sched_barrier(0); }
#undef EPO_LD
    }
};

template <class Epi, class Sched>
DI void gemm_phase(LAS unsigned char* lds, const Gemm g, const Sched& S, const Epi& E) {
    int tid_ = threadIdx.x; asm volatile("" : "+v"(tid_));
    const int tid = tid_, wid = __builtin_amdgcn_readfirstlane(tid >> 6), lane = tid & 63, wr = wid >> 2, wc = wid & 3, fr = lane & 15, fq = lane >> 4;
    const int K = g.K, nt = K / BK;
    unsigned voffA[2], voffB[2];
#pragma unroll
    for (int i = 0; i < 2; ++i) { int R, C; stage_rc(tid * 16 + i * 8192, R, C); const int Rb = Epi::PERM ? ((R & ~31) + perm32(R & 31)) : R;
        voffA[i] = (unsigned)(R * K + C) * 2u; voffB[i] = (unsigned)(Rb * K + C) * 2u; }
    const size_t kstep = (size_t)(BK * 2);
    const size_t hstep = (size_t)HALF * K * 2;
    const size_t tstep = 2 * hstep;
    const unsigned ldsw = (unsigned)wid * 1024u;
    const int aoff = lds_byte(wr * 64 + fr, fq * 8), boff = lds_byte(wc * 32 + fr, fq * 8);
#define PG8_SA(b, h) (((b) * 2 + (h)) * HTB)
#define PG8_SB(b, h) ((4 + (b) * 2 + (h)) * HTB)
#define PG8_STAGE(bufoff, gbase, voff) do { _Pragma("unroll") for (int _i = 0; _i < 2; ++_i) \
        __builtin_amdgcn_global_load_lds((const unsigned*)((const char*)(gbase) + (voff)[_i]), (LAS unsigned*)(lds + (bufoff) + ldsw + _i * 8192), 16, 0, 0); } while (0)
#define PG8_LDA(dst, b, h) do { _Pragma("unroll") for (int m = 0; m < 4; ++m) _Pragma("unroll") for (int k = 0; k < 2; ++k) dst[m][k] = *(const LAS bf16x8*)(lds + PG8_SA(b, h) + aoff + m * 2048 + k * 1024); } while (0)
#define PG8_LDB(dst, b, h) do { _Pragma("unroll") for (int n = 0; n < 2; ++n) _Pragma("unroll") for (int k = 0; k < 2; ++k) dst[n][k] = *(const LAS bf16x8*)(lds + PG8_SB(b, h) + boff + n * 2048 + k * 1024); } while (0)
#define PG8_MMA(ai, bj, At, Bt) do { __builtin_amdgcn_s_setprio(1); _Pragma("unroll") for (int m = 0; m < 4; ++m) _Pragma("unroll") for (int n = 0; n < 2; ++n) _Pragma("unroll") for (int k = 0; k < 2; ++k) \
        acc[ai][bj][m][n] = __builtin_amdgcn_mfma_f32_16x16x32_bf16(Bt[n][k], At[m][k], acc[ai][bj][m][n], 0, 0, 0); __builtin_amdgcn_s_setprio(0); } while (0)
#define PG8_WAIT_V(n) asm volatile("s_waitcnt vmcnt(" #n ")" ::: "memory")
#define PG8_WAIT_L(n) asm volatile("s_waitcnt lgkmcnt(" #n ")" ::: "memory")
#define PG8_BAR __builtin_amdgcn_s_barrier()
#define PG8_SCHED __builtin_amdgcn_sched_barrier(0)
    Unit cur, nxt; int ui = 0;
    if (!S.next(0, cur)) return;
    f32x4 acc[2][2][4][2];
#pragma unroll
    for (int a = 0; a < 2; ++a)
#pragma unroll
        for (int b = 0; b < 2; ++b)
#pragma unroll
            for (int m = 0; m < 4; ++m)
#pragma unroll
                for (int n = 0; n < 2; ++n) acc[a][b][m][n] = (f32x4){0.f, 0.f, 0.f, 0.f};
    bf16x8 At[4][2], B0[2][2], B1[2][2];
    const char* cA = (const char*)g.A + (size_t)cur.pm * tstep; const char* cB = (const char*)g.Bt + (size_t)cur.pn * tstep;
    PG8_STAGE(PG8_SB(0, 0), cB, voffB); PG8_STAGE(PG8_SA(0, 0), cA, voffA); PG8_STAGE(PG8_SB(0, 1), cB + hstep, voffB); PG8_STAGE(PG8_SA(0, 1), cA + hstep, voffA);
    if (wr == 1) PG8_BAR;
    PG8_WAIT_V(4); PG8_BAR;
    PG8_STAGE(PG8_SB(1, 0), cB + kstep, voffB); PG8_STAGE(PG8_SA(1, 0), cA + kstep, voffA); PG8_STAGE(PG8_SB(1, 1), cB + hstep + kstep, voffB);
    PG8_WAIT_V(6); PG8_BAR;
    for (;;) {
        const bool has_next = S.next(ui + 1, nxt);
        const char* nA = has_next ? (const char*)g.A + (size_t)nxt.pm * tstep : cA; const char* nB = has_next ? (const char*)g.Bt + (size_t)nxt.pn * tstep : cB;
        for (int t = 0; t < nt; t += 2) {
            const bool last = (t == nt - 2);
            const char* a1 = cA + (size_t)(t + 1) * kstep;
            const char* a2 = last ? nA : cA + (size_t)(t + 2) * kstep; const char* b2 = last ? nB : cB + (size_t)(t + 2) * kstep;
            const char* a3 = a2 + kstep; const char* b3 = b2 + kstep;
            PG8_LDB(B0, 0, 0); PG8_SCHED; PG8_LDA(At, 0, 0); PG8_STAGE(PG8_SA(1, 1), a1 + hstep, voffA);
            PG8_WAIT_L(8); PG8_BAR; PG8_WAIT_L(0); PG8_MMA(0, 0, At, B0); PG8_BAR; PG8_SCHED;
            PG8_LDB(B1, 0, 1); PG8_STAGE(PG8_SB(0, 0), b2, voffB);
            PG8_BAR; PG8_WAIT_L(0); PG8_MMA(0, 1, At, B1); PG8_BAR;
            PG8_LDA(At, 0, 1); PG8_STAGE(PG8_SA(0, 0), a2, voffA);
            PG8_BAR; PG8_WAIT_L(0); PG8_MMA(1, 0, At, B0); PG8_BAR; PG8_SCHED;
            PG8_STAGE(PG8_SB(0, 1), b2 + hstep, voffB);
            PG8_WAIT_V(6); PG8_BAR; PG8_MMA(1, 1, At, B1); PG8_BAR;
            PG8_LDB(B0, 1, 0); PG8_SCHED; PG8_LDA(At, 1, 0); PG8_STAGE(PG8_SA(0, 1), a2 + hstep, voffA);
            PG8_WAIT_L(8); PG8_BAR; PG8_WAIT_L(0); PG8_MMA(0, 0, At, B0); PG8_BAR; PG8_SCHED;
            PG8_LDB(B1, 1, 1); PG8_STAGE(PG8_SB(1, 0), b3, voffB);
            PG8_BAR; PG8_WAIT_L(0); PG8_MMA(0, 1, At, B1); PG8_BAR;
            PG8_LDA(At, 1, 1); PG8_STAGE(PG8_SA(1, 0), a3, voffA);
            PG8_BAR; PG8_WAIT_L(0); PG8_MMA(1, 0, At, B0); PG8_BAR; PG8_SCHED;
            PG8_STAGE(PG8_SB(1, 1), b3 + hstep, voffB);
            PG8_WAIT_V(6); PG8_BAR; PG8_MMA(1, 1, At, B1); PG8_BAR;
        }
        E(acc, cur, wr, wc, fr, fq, lds);
        if (!has_next) break;
#pragma unroll
        for (int a = 0; a < 2; ++a)
#pragma unroll
            for (int b = 0; b < 2; ++b)
#pragma unroll
                for (int m = 0; m < 4; ++m)
#pragma unroll
                    for (int n = 0; n < 2; ++n) acc[a][b][m][n] = (f32x4){0.f, 0.f, 0.f, 0.f};
        cur = nxt; cA = nA; cB = nB; ++ui;
    }
    PG8_WAIT_V(0);
    if (wr == 0) PG8_BAR;
    PG8_BAR;
#undef PG8_SA
#undef PG8_SB
#undef PG8_STAGE
#undef PG8_LDA
#undef PG8_LDB
#undef PG8_MMA
#undef PG8_WAIT_V
#undef PG8_WAIT_L
#undef PG8_BAR
#undef PG8_SCHED
}
}

constexpr float THR = 8.f;
constexpr int STG = 16384;
constexpr int KST_OFF = 0, VST_OFF = 65536, WSL_OFF = 131072, RPB_OFF = 133120;
#define KSWZ(row, colB) ((row) * 256 + ((colB) ^ (((row) & 7) << 4)))
#define SBAR() __builtin_amdgcn_sched_barrier(0)
DI int crow(int r, int hi) { return (r & 3) + 8 * (r >> 2) + 4 * hi; }

struct AttnArgs {
    const bf16_t* Q; long ldq;
    const bf16_t* K0; const bf16_t* V0; long ld0; int n0;
    const bf16_t* K1; const bf16_t* V1; long ld1; int n1; int s1_start, s1_max;
    int mode;
    int qpos0, r0, rbase;
    int has_sink; float sinkl2;
    int out_mode;
    bf16_t* O; long ldo; const bf16_t* Gp; long ldg;
    int fuse; const float* subln; float lam;
};

DI void apply_mask(f32x16& p0, f32x16& p1, const AttnArgs& a, int j, int wid, int r32, int hi, const LAS float* rpbL) {
    if (a.mode == 0 || j < a.n0) return;
    { int l2 = r32 | (hi << 5); asm volatile("" : "+v"(l2)); r32 = l2 & 31; hi = l2 >> 5; }
    const int jl = j - a.n0;
#ifndef ATT_NOMODE1
    if (a.mode == 1) {
        const int kbase = a.s1_start + jl * 64;
        const bool tv = (kbase >= 0) && (kbase < 4096);
        int dqh = tv ? (kbase - (a.qpos0 + wid * 32 + r32) + 4 * hi + 128) : 1000000;
        asm volatile("" : "+v"(dqh));
#pragma unroll
        for (int r = 0; r < 16; ++r) { const int cq = (r & 3) + 8 * (r >> 2);
            p0[r] = ((unsigned)(dqh + cq) <= 256u) ? p0[r] : -1e30f;
            p1[r] = ((unsigned)(dqh + cq + 32) <= 256u) ? p1[r] : -1e30f; }
    }
#else
    if (0) {}
#endif
#ifndef ATT_NOMODE2
    else {
        const int kr = a.rbase + jl, r = a.r0 + (wid >> 1); const int rs = min(max(r - 4, 0), 56);
        const bool tv = (kr >= rs) && (kr < rs + 8);
        if (!tv) {
#pragma unroll
            for (int q = 0; q < 16; ++q) { p0[q] = -1e30f; p1[q] = -1e30f; }
        } else {
            const int c = (wid & 1) * 32 + r32; const int cs = min(max(c - 8, 0), 48);
            int tq = 4 * hi - cs;
            int bidx = (kr - r + 7) * 31 + 15 - c + 4 * hi;
            asm volatile("" : "+v"(tq), "+v"(bidx));
            const LAS float* bp = rpbL + bidx;
#pragma unroll
            for (int q = 0; q < 16; ++q) { const int cq = (q & 3) + 8 * (q >> 2);
                const float b0 = bp[cq], b1 = bp[cq + 32];
                p0[q] = ((unsigned)(tq + cq) < 16u) ? p0[q] + b0 : -1e30f; p1[q] = ((unsigned)(tq + cq + 32) < 16u) ? p1[q] + b1 : -1e30f;
                if ((q & 3) == 3) SBAR(); }
        }
    }
#endif
}
DI bool tile_dead(const AttnArgs& a, int j, int wid) {
    if (a.mode == 0 || j < a.n0) return false;
    const int jl = j - a.n0;
    if (a.mode == 1) { const int kbase = a.s1_start + jl * 64, qlo = a.qpos0 + wid * 32;
        return !((kbase >= 0) && (kbase < 4096) && (kbase + 63 >= qlo - 128) && (kbase <= qlo + 31 + 128)); }
    const int kr = a.rbase + jl, r = a.r0 + (wid >> 1); const int rs = min(max(r - 4, 0), 56);
    return !((kr >= rs) && (kr < rs + 8));
}
DI void partialSM(f32x16& p0, f32x16& p1, float& m_reg, float& mn, float& alpha) {
    constexpr float C = SCALE * LOG2E;
    float pmax = p0[0];
#pragma unroll
    for (int r = 1; r < 16; ++r) pmax = fmaxf(pmax, p0[r]);
#pragma unroll
    for (int r = 0; r < 16; ++r) pmax = fmaxf(pmax, p1[r]);
    { auto rr = __builtin_amdgcn_permlane32_swap(__float_as_uint(pmax), __float_as_uint(pmax), false, false);
      pmax = fmaxf(__uint_as_float(rr[0]), __uint_as_float(rr[1])); }
    if (__builtin_expect(__all(pmax - m_reg <= THR / SCALE), 1)) { mn = m_reg; alpha = 1.f; }
    else { mn = fmaxf(m_reg, pmax); alpha = __builtin_amdgcn_exp2f((m_reg - mn) * C); m_reg = mn; }
    const float mnC = -mn * C;
#pragma unroll
    for (int r = 0; r < 16; ++r) p0[r] = fmaf(p0[r], C, mnC);
#pragma unroll
    for (int r = 0; r < 16; ++r) p1[r] = fmaf(p1[r], C, mnC);
#pragma unroll
    for (int r = 0; r < 16; ++r) p0[r] = __builtin_amdgcn_exp2f(p0[r]);
}
DI void finishSM(f32x16& p0, f32x16& p1, float alpha, float& l_reg, bf16x8& pa0, bf16x8& pa1, bf16x8& pa2, bf16x8& pa3) {
#pragma unroll
    for (int r = 0; r < 16; ++r) p1[r] = __builtin_amdgcn_exp2f(p1[r]);
    float ps = 0;
#pragma unroll
    for (int r = 0; r < 16; ++r) ps += p0[r];
#pragma unroll
    for (int r = 0; r < 16; ++r) ps += p1[r];
    { auto rr = __builtin_amdgcn_permlane32_swap(__float_as_uint(ps), __float_as_uint(ps), false, false);
      ps = __uint_as_float(rr[0]) + __uint_as_float(rr[1]); }
    l_reg = l_reg * alpha + ps;
#define PK4(P, BASE, OUT) do { unsigned a0 = cvtpk(P[BASE + 0], P[BASE + 1]), a1 = cvtpk(P[BASE + 2], P[BASE + 3]);   \
    unsigned b0 = cvtpk(P[BASE + 4], P[BASE + 5]), b1 = cvtpk(P[BASE + 6], P[BASE + 7]);                              \
    auto r0 = __builtin_amdgcn_permlane32_swap(a0, b0, false, false); auto r1 = __builtin_amdgcn_permlane32_swap(a1, b1, false, false); \
    u32x4 w = {r0[0], r1[0], r0[1], r1[1]}; OUT = *reinterpret_cast<bf16x8*>(&w); } while (0)
    PK4(p0, 0, pa0); PK4(p0, 8, pa1); PK4(p1, 0, pa2); PK4(p1, 8, pa3);
#undef PK4
}
DI void qkt(f32x16& p0, f32x16& p1, const LAS unsigned char* Ks, const bf16x8* qr, int r32, int hi) {
    p0 = f32x16{}; p1 = f32x16{};
    { int l2 = r32 | (hi << 5); asm volatile("" : "+v"(l2)); r32 = l2 & 31; hi = l2 >> 5; }
#pragma unroll
    for (int d0 = 0; d0 < 8; ++d0) { const int cb = (d0 * 16 + hi * 8) * 2;
        bf16x8 b0 = *reinterpret_cast<const LAS bf16x8*>(Ks + KSWZ(r32, cb));
        bf16x8 b1 = *reinterpret_cast<const LAS bf16x8*>(Ks + KSWZ(32 + r32, cb));
        p0 = __builtin_amdgcn_mfma_f32_32x32x16_bf16(b0, qr[d0], p0, 0, 0, 0);
        p1 = __builtin_amdgcn_mfma_f32_32x32x16_bf16(b1, qr[d0], p1, 0, 0, 0);
        if (d0 == 3) SBAR(); }
}
DI int v_st(int k, int c) { const int kk = (k & ~0xC) | ((k & 4) << 1) | ((k & 8) >> 1); return ((kk >> 3) * 4 + (c >> 5)) * 512 + ((kk & 7) * 32 + (c & 31)) * 2; }
DI int v_rd_base(int lane) { return ((lane & 3) << 3) | (((lane >> 2) & 3) << 6) | (((lane >> 4) & 1) << 5) | (((lane >> 5) & 1) << 8); }
constexpr int v_rd_off(int d0, int ks, int half) { return d0 * 512 + ks * 4096 + half * 2048; }
template <int OFF> DI s16x4 tr_read(int vb) {
    s16x4 r; asm volatile("ds_read_b64_tr_b16 %0, %1 offset:%2" : "=&v"(r) : "v"(vb), "i"(OFF) : "memory"); return r;
}
template <int D0> DI void pv_one(f32x16& od, int vb, bf16x8 pa0, bf16x8 pa1, bf16x8 pa2, bf16x8 pa3) {
    const s16x4 l0 = tr_read<v_rd_off(D0, 0, 0)>(vb), h0 = tr_read<v_rd_off(D0, 0, 1)>(vb), l1 = tr_read<v_rd_off(D0, 1, 0)>(vb), h1 = tr_read<v_rd_off(D0, 1, 1)>(vb);
    const s16x4 l2 = tr_read<v_rd_off(D0, 2, 0)>(vb), h2 = tr_read<v_rd_off(D0, 2, 1)>(vb), l3 = tr_read<v_rd_off(D0, 3, 0)>(vb), h3 = tr_read<v_rd_off(D0, 3, 1)>(vb);
    asm volatile("s_waitcnt lgkmcnt(0)" ::: "memory"); SBAR();
#define PK(L, H) (bf16x8){L[0], L[1], L[2], L[3], H[0], H[1], H[2], H[3]}
    od = __builtin_amdgcn_mfma_f32_32x32x16_bf16(pa0, PK(l0, h0), od, 0, 0, 0);
    od = __builtin_amdgcn_mfma_f32_32x32x16_bf16(pa1, PK(l1, h1), od, 0, 0, 0);
    od = __builtin_amdgcn_mfma_f32_32x32x16_bf16(pa2, PK(l2, h2), od, 0, 0, 0);
    od = __builtin_amdgcn_mfma_f32_32x32x16_bf16(pa3, PK(l3, h3), od, 0, 0, 0);
#undef PK
}
#define PV_RD(S, D0, VB) const s16x4 S##l0 = tr_read<v_rd_off(D0, 0, 0)>(VB), S##h0 = tr_read<v_rd_off(D0, 0, 1)>(VB), S##l1 = tr_read<v_rd_off(D0, 1, 0)>(VB), S##h1 = tr_read<v_rd_off(D0, 1, 1)>(VB), \
                               S##l2 = tr_read<v_rd_off(D0, 2, 0)>(VB), S##h2 = tr_read<v_rd_off(D0, 2, 1)>(VB), S##l3 = tr_read<v_rd_off(D0, 3, 0)>(VB), S##h3 = tr_read<v_rd_off(D0, 3, 1)>(VB)
#define PV_PK(L, H) (bf16x8){L[0], L[1], L[2], L[3], H[0], H[1], H[2], H[3]}
#define PV_MM(S, OD) do { OD = __builtin_amdgcn_mfma_f32_32x32x16_bf16(pa0, PV_PK(S##l0, S##h0), OD, 0, 0, 0); OD = __builtin_amdgcn_mfma_f32_32x32x16_bf16(pa1, PV_PK(S##l1, S##h1), OD, 0, 0, 0); \
                          OD = __builtin_amdgcn_mfma_f32_32x32x16_bf16(pa2, PV_PK(S##l2, S##h2), OD, 0, 0, 0); OD = __builtin_amdgcn_mfma_f32_32x32x16_bf16(pa3, PV_PK(S##l3, S##h3), OD, 0, 0, 0); } while (0)
#define PV_W8() do { asm volatile("s_waitcnt lgkmcnt(8)" ::: "memory"); SBAR(); } while (0)
#define PV_W0() do { asm volatile("s_waitcnt lgkmcnt(0)" ::: "memory"); SBAR(); } while (0)
template <int NH> DI void pv_pipe(f32x16* o, int vb, bf16x8 pa0, bf16x8 pa1, bf16x8 pa2, bf16x8 pa3) {
    SBAR();
    { PV_RD(a, 0, vb); SBAR();
      { PV_RD(b, 1, vb); PV_W8(); PV_MM(a, o[0]); SBAR();
        { PV_RD(c, 2, vb); PV_W8(); PV_MM(b, o[1]); SBAR();
          { PV_RD(d, 3, vb); PV_W8(); PV_MM(c, o[2]); SBAR();
            if constexpr (NH == 1) { PV_W0(); PV_MM(d, o[3]); SBAR(); }
            else { const int vb2 = vb + STG;
              { PV_RD(e, 0, vb2); PV_W8(); PV_MM(d, o[3]); SBAR();
                { PV_RD(f, 1, vb2); PV_W8(); PV_MM(e, o[4]); SBAR();
                  { PV_RD(g, 2, vb2); PV_W8(); PV_MM(f, o[5]); SBAR();
                    { PV_RD(h, 3, vb2); PV_W8(); PV_MM(g, o[6]); SBAR();
                      PV_W0(); PV_MM(h, o[7]); SBAR(); } } } } } } } } }
}
DI void pv_d0(f32x16* o, int vb, bf16x8 pa0, bf16x8 pa1, bf16x8 pa2, bf16x8 pa3) { pv_pipe<1>(o, vb, pa0, pa1, pa2, pa3); }

DI void attn_body(const AttnArgs& a, LAS unsigned char* lds) {
    int tid_ = threadIdx.x; asm volatile("" : "+v"(tid_));
    const int tid = tid_, wid = __builtin_amdgcn_readfirstlane(tid >> 6), lane = tid & 63, r32 = lane & 31, hi = lane >> 5;
    LAS unsigned char* Kst = lds + KST_OFF; LAS unsigned char* Vst = lds + VST_OFF;
    LAS float* wsl = (LAS float*)(lds + WSL_OFF) + wid * 64; LAS float* li_l = wsl; LAS float* al_l = wsl + 32;
    const LAS float* rpbL = (const LAS float*)(lds + RPB_OFF);
    float m_reg = -1e30f, l_reg = 0; f32x16 o[4] = {}; bf16x8 qr[8];
    const bf16_t* Qw = a.Q + (long)(wid * 32 + r32) * a.ldq + hi * 8;
#pragma unroll
    for (int d0 = 0; d0 < 8; ++d0) qr[d0] = *reinterpret_cast<const bf16x8*>(Qw + d0 * 16);
    const int vb0 = (int)(size_t)Vst + v_rd_base(lane);
#define ISSUE(jt, ST) do { const int _j = (jt); const char* _k; const char* _v; unsigned _ld;                                   \
    if (_j < a.n0) { _ld = (unsigned)a.ld0 * 2u; const size_t _o = (size_t)_j * 64 * _ld; _k = (const char*)a.K0 + _o; _v = (const char*)a.V0 + _o; }                         \
    else { int _st = a.s1_start + (_j - a.n0) * 64; _st = max(0, min(_st, a.s1_max)); _ld = (unsigned)a.ld1 * 2u; const size_t _o = (size_t)_st * _ld; _k = (const char*)a.K1 + _o; _v = (const char*)a.V1 + _o; } \
    unsigned _ln = (unsigned)lane; asm volatile("" : "+v"(_ln));                                                                  \
    _Pragma("unroll") for (int _i = 0; _i < 2; ++_i) { const unsigned _s = (unsigned)((wid * 2 + _i) * 64) + _ln;                 \
        const unsigned _rk = _s >> 4, _ck = ((_s & 15u) << 4) ^ ((_rk & 7u) << 4);                                                \
        const unsigned _sub = _s >> 5, _w5 = _s & 31u, _kk = (_sub >> 2) * 8u + (_w5 >> 2);                                         \
        const unsigned _rv = (_kk & ~0xCu) | ((_kk & 4u) << 1) | ((_kk & 8u) >> 1), _cv = ((_sub & 3u) * 32u + (_w5 & 3u) * 8u) * 2u; \
        unsigned _ok = _rk * _ld + _ck, _ov = _rv * _ld + _cv; asm volatile("" : "+v"(_ok), "+v"(_ov));                           \
        __builtin_amdgcn_global_load_lds((const unsigned*)(_k + _ok), (LAS unsigned*)(Kst + (ST) * STG + (wid * 2 + _i) * 1024), 16, 0, 0); \
        __builtin_amdgcn_global_load_lds((const unsigned*)(_v + _ov), (LAS unsigned*)(Vst + (ST) * STG + (wid * 2 + _i) * 1024), 16, 0, 0); } } while (0)
#define WAITV(n) asm volatile("s_waitcnt vmcnt(" #n ")" ::: "memory")
#define BAR() do { asm volatile("s_waitcnt lgkmcnt(0)" ::: "memory"); __builtin_amdgcn_s_barrier(); asm volatile("" ::: "memory"); SBAR(); } while (0)
#define RESC(al) do { if (__any((al) < 1.f)) { if (hi == 0) al_l[r32] = (al); asm volatile("s_waitcnt lgkmcnt(0)" ::: "memory"); \
    _Pragma("unroll") for (int d = 0; d < 4; ++d) _Pragma("unroll") for (int r = 0; r < 16; ++r) o[d][r] *= al_l[crow(r, hi)]; } } while (0)
    f32x16 pA0, pA1, pB0, pB1; float mnA, mnB, alA, alB; bf16x8 pa0, pa1, pa2, pa3; const int NT = a.n0 + a.n1;
#define STEP(X0, X1, mnX, alX, deadX, Y0, Y1, alY, deadY, jt, KS, VS) do { const int _jj = (jt);                                    \
    deadX = tile_dead(a, _jj, wid);                                                                                               \
    SBAR(); if (!deadX) qkt(X0, X1, Kst + (KS) * STG, qr, r32, hi);                                                               \
    else { _Pragma("unroll") for (int _q = 0; _q < 16; ++_q) { X0[_q] = -1e30f; X1[_q] = -1e30f; } }                              \
    SBAR();                                                                                                                       \
    if (!deadY) finishSM(Y0, Y1, alY, l_reg, pa0, pa1, pa2, pa3);                                                                 \
    SBAR();                                                                                                                       \
    if (_jj + 2 < NT) ISSUE(_jj + 2, ((KS) + 2) & 3);                                                                             \
    SBAR();                                                                                                                       \
    if (!deadY) pv_d0(o, vb0 + (VS) * STG, pa0, pa1, pa2, pa3);                                                                   \
    SBAR(); if (!deadX) { apply_mask(X0, X1, a, _jj, wid, r32, hi, rpbL); SBAR(); partialSM(X0, X1, m_reg, mnX, alX); RESC(alX); } \
    if (_jj + 2 < NT) WAITV(4); else WAITV(0);                                                                                    \
    BAR(); } while (0)
    bool deadA = false, deadB = false;
    ISSUE(0, 0); ISSUE(1, 1);
    WAITV(4); BAR();
    SBAR(); qkt(pA0, pA1, Kst, qr, r32, hi); SBAR();
    ISSUE(2, 2);
    SBAR(); apply_mask(pA0, pA1, a, 0, wid, r32, hi, rpbL); partialSM(pA0, pA1, m_reg, mnA, alA);
    WAITV(4); BAR();
#pragma unroll 1
    for (int j = 1; j < NT; j += 4) {
        STEP(pB0, pB1, mnB, alB, deadB, pA0, pA1, alA, deadA, j, 1, 0);
        STEP(pA0, pA1, mnA, alA, deadA, pB0, pB1, alB, deadB, j + 1, 2, 1);
        STEP(pB0, pB1, mnB, alB, deadB, pA0, pA1, alA, deadA, j + 2, 3, 2);
        if (j + 3 < NT) STEP(pA0, pA1, mnA, alA, deadA, pB0, pB1, alB, deadB, j + 3, 0, 3);
    }
    if (!deadB) { finishSM(pB0, pB1, alB, l_reg, pa0, pa1, pa2, pa3); SBAR();
        pv_d0(o, vb0 + 3 * STG, pa0, pa1, pa2, pa3); }
    if (a.has_sink) l_reg += __builtin_amdgcn_exp2f(a.sinkl2 - m_reg * (SCALE * LOG2E));
    if (hi == 0) li_l[r32] = l_reg; asm volatile("s_waitcnt lgkmcnt(0)" ::: "memory");
    float rli[16];
#pragma unroll
    for (int r = 0; r < 16; ++r) rli[r] = __builtin_amdgcn_rcpf(li_l[crow(r, hi)]);
    {
        int wu = wid; unsigned rl = (unsigned)r32 * 2u;
        asm volatile("" : "+s"(wu), "+v"(rl));
        char* Ow = (char*)(a.O + (size_t)(wu * 32) * a.ldo); const char* Gw = (const char*)(a.Gp + (size_t)(wu * 32) * a.ldg);
        const unsigned ldo2 = (unsigned)a.ldo * 2u, ldg2 = (unsigned)a.ldg * 2u;
        if (a.out_mode == 0) {
            BAR();
            unsigned ln = (unsigned)lane; asm volatile("" : "+v"(ln));
            u32x4 gw[8];
#pragma unroll
            for (int i = 0; i < 8; ++i) { const unsigned c = (unsigned)i * 64u + ln; gw[i] = *(const u32x4*)(Gw + (c >> 4) * ldg2 + (c & 15u) * 16u); }
            LAS float* img = (LAS float*)(lds + (unsigned)wu * 16384u);
            const unsigned wbase = (unsigned)hi * 4u * 128u + (ln & 31u);
#pragma unroll
            for (int r = 0; r < 16; ++r) { const unsigned ro = wbase + (unsigned)((r & 3) + 8 * (r >> 2)) * 128u;
                img[ro] = o[0][r] * rli[r]; img[ro + 32] = o[1][r] * rli[r]; img[ro + 64] = o[2][r] * rli[r]; img[ro + 96] = o[3][r] * rli[r]; }
            asm volatile("s_waitcnt lgkmcnt(0)" ::: "memory");
#pragma unroll
            for (int i = 0; i < 8; ++i) { const unsigned c = (unsigned)i * 64u + ln; const unsigned row = c >> 4, c8 = (c & 15u) * 8u;
                const f32x4 x0 = *(const LAS f32x4*)(img + row * 128u + c8), x1 = *(const LAS f32x4*)(img + row * 128u + c8 + 4);
                const u32x4 g = gw[i]; u32x4 w;
                w.x = cvtpk(x0[0] * silu_f(bf_lo(g.x)), x0[1] * silu_f(bf_hi(g.x))); w.y = cvtpk(x0[2] * silu_f(bf_lo(g.y)), x0[3] * silu_f(bf_hi(g.y)));
                w.z = cvtpk(x1[0] * silu_f(bf_lo(g.z)), x1[1] * silu_f(bf_hi(g.z))); w.w = cvtpk(x1[2] * silu_f(bf_lo(g.w)), x1[3] * silu_f(bf_hi(g.w)));
                *(u32x4*)(Ow + row * ldo2 + c8 * 2u) = w; }
        } else {
#pragma unroll
            for (int r = 0; r < 16; ++r) { const unsigned orow = (unsigned)crow(r, hi); const unsigned oo = orow * ldo2 + rl;
                const float v0 = o[0][r] * rli[r], v1 = o[1][r] * rli[r], v2 = o[2][r] * rli[r], v3 = o[3][r] * rli[r];
                *(bf16_t*)(Ow + oo) = (bf16_t)(cvtpk(v0, 0.f) & 0xffffu); *(bf16_t*)(Ow + oo + 64) = (bf16_t)(cvtpk(v1, 0.f) & 0xffffu);
                *(bf16_t*)(Ow + oo + 128) = (bf16_t)(cvtpk(v2, 0.f) & 0xffffu); *(bf16_t*)(Ow + oo + 192) = (bf16_t)(cvtpk(v3, 0.f) & 0xffffu); }
        }
    }
#undef ISSUE
#undef WAITV
#undef BAR
#undef RESC
#undef STEP
}

constexpr int BK_OFF = 0, BV_OFF = 49152, BWSL_OFF = 147456;
DI void attn_body_b(const AttnArgs& a, LAS unsigned char* lds) {
    int tid_ = threadIdx.x; asm volatile("" : "+v"(tid_));
    const int tid = tid_, wid = __builtin_amdgcn_readfirstlane(tid >> 6), lane = tid & 63, r32 = lane & 31, hi = lane >> 5;
    LAS unsigned char* Kst = lds + BK_OFF; LAS unsigned char* Vst = lds + BV_OFF;
    LAS float* wsl = (LAS float*)(lds + BWSL_OFF) + wid * 64; LAS float* li_l = wsl; LAS float* al_l = wsl + 32;
    float m_reg = -1e30f, l_reg = 0; f32x16 o[8] = {}; bf16x8 qr[8];
    const bf16_t* Qw = a.Q + (long)(wid * 32 + r32) * a.ldq + hi * 8;
#pragma unroll
    for (int d0 = 0; d0 < 8; ++d0) qr[d0] = *reinterpret_cast<const bf16x8*>(Qw + d0 * 16);
    const int vb0 = (int)(size_t)Vst + v_rd_base(lane);
#define ISSUEB(jt, ST) do { const int _j = (jt); const char* _k; const char* _v; unsigned _ld;                                   \
    if (_j < a.n0) { _ld = (unsigned)a.ld0 * 2u; const size_t _o = (size_t)_j * 64 * _ld; _k = (const char*)a.K0 + _o; _v = (const char*)a.V0 + _o; }                         \
    else { int _st = a.s1_start + (_j - a.n0) * 64; _st = max(0, min(_st, a.s1_max)); _ld = (unsigned)a.ld1 * 2u; const size_t _o = (size_t)_st * _ld; _k = (const char*)a.K1 + _o; _v = (const char*)a.V1 + _o; } \
    unsigned _ln = (unsigned)lane; asm volatile("" : "+v"(_ln));                                                                  \
    _Pragma("unroll") for (int _i = 0; _i < 2; ++_i) { const unsigned _s = (unsigned)((wid * 2 + _i) * 64) + _ln;                 \
        const unsigned _rk = _s >> 4, _ck = ((_s & 15u) << 4) ^ ((_rk & 7u) << 4);                                                \
        const unsigned _sub = _s >> 5, _w5 = _s & 31u, _kk = (_sub >> 2) * 8u + (_w5 >> 2);                                         \
        const unsigned _rv = (_kk & ~0xCu) | ((_kk & 4u) << 1) | ((_kk & 8u) >> 1), _cv = ((_sub & 3u) * 32u + (_w5 & 3u) * 8u) * 2u; \
        unsigned _ok = _rk * _ld + _ck, _ov = _rv * _ld + _cv; asm volatile("" : "+v"(_ok), "+v"(_ov));                           \
        __builtin_amdgcn_global_load_lds((const unsigned*)(_k + _ok), (LAS unsigned*)(Kst + (ST) * STG + (wid * 2 + _i) * 1024), 16, 0, 0); \
        __builtin_amdgcn_global_load_lds((const unsigned*)(_v + _ov), (LAS unsigned*)(Vst + (ST) * 2 * STG + (wid * 2 + _i) * 1024), 16, 0, 0); \
        __builtin_amdgcn_global_load_lds((const unsigned*)(_v + 256 + _ov), (LAS unsigned*)(Vst + (ST) * 2 * STG + STG + (wid * 2 + _i) * 1024), 16, 0, 0); } } while (0)
#define WAITV(n) asm volatile("s_waitcnt vmcnt(" #n ")" ::: "memory")
#define BAR() do { asm volatile("s_waitcnt lgkmcnt(0)" ::: "memory"); __builtin_amdgcn_s_barrier(); asm volatile("" ::: "memory"); SBAR(); } while (0)
    const int NT = a.n0 + a.n1;
    ISSUEB(0, 0);
    int st = 0;
#pragma unroll 1
    for (int j = 0; j < NT; ++j) {
        const int stn = (st == 2) ? 0 : st + 1;
        if (j + 1 < NT) { ISSUEB(j + 1, stn); WAITV(6); } else WAITV(0);
        BAR();
        f32x16 p0, p1; float mn, alpha; bf16x8 pa0, pa1, pa2, pa3;
        qkt(p0, p1, Kst + st * STG, qr, r32, hi); SBAR();
        partialSM(p0, p1, m_reg, mn, alpha);
        finishSM(p0, p1, alpha, l_reg, pa0, pa1, pa2, pa3); SBAR();
        if (__any(alpha < 1.f)) { if (hi == 0) al_l[r32] = alpha; asm volatile("s_waitcnt lgkmcnt(0)" ::: "memory");
#pragma unroll
            for (int d = 0; d < 8; ++d)
#pragma unroll
                for (int r = 0; r < 16; ++r) o[d][r] *= al_l[crow(r, hi)]; }
        SBAR();
        const int vb = vb0 + st * 2 * STG;
        pv_pipe<2>(o, vb, pa0, pa1, pa2, pa3);
        st = stn;
    }
    if (hi == 0) li_l[r32] = l_reg;
    BAR();
    {
        int wu = wid; unsigned ln = (unsigned)lane;
        asm volatile("" : "+s"(wu), "+v"(ln));
        char* Ow = (char*)(a.O + (size_t)(wu * 32) * a.ldo); const unsigned ldo2 = (unsigned)a.ldo * 2u;
        LAS unsigned char* img = lds + (unsigned)wu * 16384u;
        const unsigned wb = (ln >> 5) * 4u * 512u + (ln & 31u) * 2u;
#pragma unroll
        for (int r = 0; r < 16; ++r) { const float rli = __builtin_amdgcn_rcpf(li_l[crow(r, hi)]); const unsigned ro = wb + (unsigned)((r & 3) + 8 * (r >> 2)) * 512u;
#pragma unroll
            for (int d = 0; d < 8; ++d) *(LAS bf16_t*)(img + ro + d * 64) = (bf16_t)(cvtpk(o[d][r] * rli, 0.f) & 0xffffu); }
        asm volatile("s_waitcnt lgkmcnt(0)" ::: "memory");
        if (!a.fuse) {
#pragma unroll
            for (int i = 0; i < 16; ++i) { const unsigned c = (unsigned)i * 64u + ln; const unsigned row = c >> 5, ch = (c & 31u) * 16u;
                *(u32x4*)(Ow + row * ldo2 + ch) = *(const LAS u32x4*)(img + row * 512u + ch); }
        } else {
            const char* Gw = (const char*)(a.Gp + (size_t)(wu * 32) * a.ldg); const unsigned ldg2 = (unsigned)a.ldg * 2u;
            const float lam = a.lam; const unsigned cc = (ln & 31u) * 8u;
            const f32x4 sb0 = *(const f32x4*)(a.subln + cc), sb1 = *(const f32x4*)(a.subln + cc + 4);
#pragma unroll 1
            for (int i0 = 0; i0 < 16; i0 += 8) {
                u32x4 w1[8], wg[8];
#pragma unroll
                for (int u = 0; u < 8; ++u) { const unsigned c = (unsigned)(i0 + u) * 64u + ln; const unsigned row = c >> 5, ch = (c & 31u) * 16u;
                    w1[u] = *(const u32x4*)(Ow + row * ldo2 + ch); wg[u] = *(const u32x4*)(Gw + row * ldg2 + ch); }
#pragma unroll
                for (int u = 0; u < 8; ++u) { const unsigned c = (unsigned)(i0 + u) * 64u + ln; const unsigned row = c >> 5, ch = (c & 31u) * 16u;
                    const u32x4 w2 = *(const LAS u32x4*)(img + row * 512u + ch);
                    float d[8] = {bf_lo(w1[u].x) - lam * bf_lo(w2.x), bf_hi(w1[u].x) - lam * bf_hi(w2.x), bf_lo(w1[u].y) - lam * bf_lo(w2.y), bf_hi(w1[u].y) - lam * bf_hi(w2.y),
                                  bf_lo(w1[u].z) - lam * bf_lo(w2.z), bf_hi(w1[u].z) - lam * bf_hi(w2.z), bf_lo(w1[u].w) - lam * bf_lo(w2.w), bf_hi(w1[u].w) - lam * bf_hi(w2.w)};
                    const float g[8] = {bf_lo(wg[u].x), bf_hi(wg[u].x), bf_lo(wg[u].y), bf_hi(wg[u].y), bf_lo(wg[u].z), bf_hi(wg[u].z), bf_lo(wg[u].w), bf_hi(wg[u].w)};
                    float ss = 0;
#pragma unroll
                    for (int q = 0; q < 8; ++q) ss += d[q] * d[q];
                    ss += shx(ss, 16, (int)ln); ss += shx(ss, 8, (int)ln); ss += shx(ss, 4, (int)ln); ss += shx(ss, 2, (int)ln); ss += shx(ss, 1, (int)ln);
                    const float rs = rsqrtf(ss * (1.f / 256.f) + 1e-6f) * (1.f - LINIT);
#pragma unroll
                    for (int q = 0; q < 8; ++q) d[q] = d[q] * rs * (q < 4 ? sb0[q & 3] : sb1[q & 3]) * silu_f(g[q]);
                    u32x4 wo; wo.x = cvtpk(d[0], d[1]); wo.y = cvtpk(d[2], d[3]); wo.z = cvtpk(d[4], d[5]); wo.w = cvtpk(d[6], d[7]);
                    *(u32x4*)(Ow + row * ldo2 + ch) = wo; }
            }
        }
    }
    BAR();
#undef ISSUEB
#undef WAITV
#undef BAR
}

DI void cvt_array(const float* src, bf16_t* dst, long n, int bid, int G, int tid) {
    for (long i = ((long)bid * NTHREADS + tid) * 8; i < n; i += (long)G * NTHREADS * 8) {
        const f32x4 a = *(const f32x4*)(src + i), b = *(const f32x4*)(src + i + 4);
        u32x4 w; w.x = cvtpk(a[0], a[1]); w.y = cvtpk(a[2], a[3]); w.z = cvtpk(b[0], b[1]); w.w = cvtpk(b[2], b[3]);
        *(u32x4*)(dst + i) = w;
    }
}

DI void cvt_array_perm(const float* src, bf16_t* dst, long n, int bid, int G, int tid) {
    for (long i = ((long)bid * NTHREADS + tid) * 8; i < n; i += (long)G * NTHREADS * 8) {
        const long vb = i & ~127L; const int L = (int)(i & 127) >> 3, ax = L >> 3, f0 = (L & 7) * 4;
        const f32x4 a = *(const f32x4*)(src + vb + 64 * ax + f0), b = *(const f32x4*)(src + vb + 64 * ax + 32 + f0);
        u32x4 w; w.x = cvtpk(a[0], b[0]); w.y = cvtpk(a[1], b[1]); w.z = cvtpk(a[2], b[2]); w.w = cvtpk(a[3], b[3]);
        *(u32x4*)(dst + i) = w;
    }
}

DI void phase0(const Params& p, char* lds) {
    int tid_ = threadIdx.x; asm volatile("" : "+v"(tid_));
    const int tid = tid_, G = gridDim.x, bid = blockIdx.x;
    unsigned char* ws = p.ws;
    float* T = (float*)lds;
    for (int it = bid; it < 17408; it += G) {
        const int ct = it >> 5, kt = it & 31;
        const float* src; bf16_t* dst; int N, n0; int qklim = 0;
        if (ct < 160) { const int jj = ct / 80; N = 5120; qklim = 2560; n0 = (ct % 80) * 64; src = p.in[16] + (size_t)jj * 2048 * 5120; dst = (bf16_t*)(ws + WS_WTA) + (size_t)jj * 5120 * 2048; }
        else if (ct < 288) { N = 8192; qklim = 4096; n0 = (ct - 160) * 64; src = p.in[18]; dst = (bf16_t*)(ws + WS_WTB); }
        else if (ct < 416) { N = 8192; qklim = 4096; n0 = (ct - 288) * 64; src = p.in[21]; dst = (bf16_t*)(ws + WS_WTC); }
        else { const int jj = (ct - 416) >> 5; N = 2048; n0 = ((ct - 416) & 31) * 64; src = p.in[13] + (size_t)jj * 2048 * 2048; dst = (bf16_t*)(ws + WS_WTO) + (size_t)jj * 2048 * 2048; }
        const int k0 = kt * 64;
        __syncthreads();
#pragma unroll
        for (int i = 0; i < 2; ++i) { const int k = (tid >> 4) + 32 * i, n4 = (tid & 15) * 4;
            const f32x4 v = *(const f32x4*)(src + (size_t)(k0 + k) * N + n0 + n4);
            T[k * 65 + n4 + 0] = v[0]; T[k * 65 + n4 + 1] = v[1]; T[k * 65 + n4 + 2] = v[2]; T[k * 65 + n4 + 3] = v[3]; }
        __syncthreads();
        { const int n = tid >> 3, k8 = (tid & 7) * 8; u32x4 w;
          w.x = cvtpk(T[(k8 + 0) * 65 + n], T[(k8 + 1) * 65 + n]); w.y = cvtpk(T[(k8 + 2) * 65 + n], T[(k8 + 3) * 65 + n]);
          w.z = cvtpk(T[(k8 + 4) * 65 + n], T[(k8 + 5) * 65 + n]); w.w = cvtpk(T[(k8 + 6) * 65 + n], T[(k8 + 7) * 65 + n]);
          int nn = n0 + n; if (nn < qklim) nn = (nn & ~127) + hd_phys(nn & 127);
          *(u32x4*)(dst + (size_t)nn * 2048 + k0 + k8) = w; }
    }
    bf16_t* cb = (bf16_t*)(ws + WS_CACHE);
    cvt_array_perm(p.in[2], cb + C_AK, 2097152, bid, G, tid); cvt_array(p.in[3], cb + C_AV, 2097152, bid, G, tid);
    cvt_array_perm(p.in[4], cb + C_BK, 4194304, bid, G, tid); cvt_array(p.in[5], cb + C_BV, 4194304, bid, G, tid);
    cvt_array_perm(p.in[6], cb + C_CK, 4194304, bid, G, tid); cvt_array(p.in[7], cb + C_CV, 4194304, bid, G, tid);
    float* scl = (float*)lds + 8192;
    float* part = (float*)(ws + WS_PART);
    for (int it = bid; it < 768; it += G) {
        const int l = it / 192, rem = it % 192, cc = rem >> 4, kc = rem & 15;
        __syncthreads();
        for (int e = tid; e < 9 * 128; e += NTHREADS) { const int r = e >> 7, k = e & 127;
            const float cv = (r == 0) ? p.in[9][kc * 128 + k] : p.in[8][(r - 1) * 2048 + kc * 128 + k]; scl[e] = silu_f(cv); }
        __syncthreads();
        const float* W = p.in[11] + ((size_t)l * 2048 + kc * 128) * 6144 + cc * 512 + tid;
        float a0 = 0, a1 = 0, a2 = 0, a3 = 0, a4 = 0, a5 = 0, a6 = 0, a7 = 0, a8 = 0;
#pragma unroll 8
        for (int k = 0; k < 128; ++k) { const float w = W[(size_t)k * 6144];
            a0 += scl[k] * w; a1 += scl[128 + k] * w; a2 += scl[256 + k] * w; a3 += scl[384 + k] * w; a4 += scl[512 + k] * w;
            a5 += scl[640 + k] * w; a6 += scl[768 + k] * w; a7 += scl[896 + k] * w; a8 += scl[1024 + k] * w; }
        float* po = part + ((size_t)(l * 16 + kc) * 9) * 6144 + cc * 512 + tid;
        po[0] = a0; po[6144] = a1; po[2 * 6144] = a2; po[3 * 6144] = a3; po[4 * 6144] = a4; po[5 * 6144] = a5; po[6 * 6144] = a6; po[7 * 6144] = a7; po[8 * 6144] = a8;
    }
    if (bid == G - 1) {
        float* ct = (float*)(ws + WS_ROPE); float* st = ct + 2048;
        for (int e = tid; e < 2048; e += NTHREADS) { const int pos = e >> 5, f = e & 31;
            double inv = 1.0; for (int q = 0; q < f; ++q) inv *= 0.74989420933245582730;
            const float invf = (float)inv; const float angf = (float)pos * invf;
            double x = (double)angf; const double twopi = 6.283185307179586476925;
            const double kq = __builtin_rint(x / twopi); x -= kq * twopi;
            const double x2 = x * x; double sn = x, cs = 1.0, ts = x, tc = 1.0;
            for (int q = 1; q <= 12; ++q) { tc *= -x2 / (double)((2 * q - 1) * (2 * q)); cs += tc; ts *= -x2 / (double)((2 * q) * (2 * q + 1)); sn += ts; }
            ct[e] = (float)cs; st[e] = (float)sn; }
    }
}

DI void ada_reduce(const Params& p) {
    int tid_ = threadIdx.x; asm volatile("" : "+v"(tid_));
    const int tid = tid_, G = gridDim.x, bid = blockIdx.x;
    unsigned char* ws = p.ws;
    const float* part = (const float*)(ws + WS_PART);
    float* modA = (float*)(ws + WS_MODA); float* modB = (float*)(ws + WS_MODB); float* gate = (float*)(ws + WS_GATE);
    for (int e = bid * NTHREADS + tid; e < 4 * 9 * 6144; e += G * NTHREADS) {
        const int j = e % 6144, lr = e / 6144, l = lr / 9, r = lr % 9;
        float m = p.in[12][l * 6144 + j];
#pragma unroll
        for (int kc = 0; kc < 16; ++kc) m += part[((size_t)(l * 16 + kc) * 9 + r) * 6144 + j];
        if (j < 2048) modB[lr * 2048 + j] = m;
        else if (j < 4096) modA[lr * 2048 + j - 2048] = p.in[10][l * 2048 + j - 2048] * (1.f + m);
        else gate[lr * 2048 + j - 4096] = m;
    }
    if (bid == 0 && tid < 64) {
        const float* lam = p.in[19]; float s1 = 0, s2 = 0;
        for (int k = tid; k < 128; k += 64) { s1 += lam[k] * lam[128 + k]; s2 += lam[256 + k] * lam[384 + k]; }
#pragma unroll
        for (int o = 32; o >= 1; o >>= 1) { s1 += shx(s1, o, tid); s2 += shx(s2, o, tid); }
        if (tid == 0) ((float*)(ws + WS_MISC))[0] = expf(s1) - expf(s2) + LINIT;
    }
}

DI void prenorm(const Params& p, int l) {
    int tid_ = threadIdx.x; asm volatile("" : "+v"(tid_));
    const int tid = tid_, G = gridDim.x, bid = blockIdx.x, wid = tid >> 6, lane = tid & 63;
    unsigned char* ws = p.ws; bf16_t* H = (bf16_t*)(ws + WS_H);
    f32x4 v[8], vn[8];
    int t = bid * 8 + wid;
#define PN_SRC(tt) ((l == 0) ? ((tt) < M_CTX ? p.in[0] + (size_t)(tt) * DM : p.in[1] + (size_t)((tt) - M_CTX) * DM) : p.out + (size_t)(tt) * DM)
    if (t < MT) { const float* x = PN_SRC(t);
#pragma unroll
        for (int i = 0; i < 8; ++i) v[i] = *(const f32x4*)(x + i * 256 + lane * 4); }
    for (; t < MT; t += G * 8) {
        const int tn = t + G * 8;
        if (tn < MT) { const float* xn = PN_SRC(tn);
#pragma unroll
            for (int i = 0; i < 8; ++i) vn[i] = *(const f32x4*)(xn + i * 256 + lane * 4); }
        const int r9 = t < M_CTX ? 0 : 1 + ((t - M_CTX) >> 12);
        const float* A = (const float*)(ws + WS_MODA) + (l * 9 + r9) * DM; const float* B = (const float*)(ws + WS_MODB) + (l * 9 + r9) * DM;
        f32x4 am[8], bm[8];
#pragma unroll
        for (int i = 0; i < 8; ++i) { am[i] = *(const f32x4*)(A + i * 256 + lane * 4); bm[i] = *(const f32x4*)(B + i * 256 + lane * 4); }
        float ss = 0;
#pragma unroll
        for (int i = 0; i < 8; ++i) ss += v[i][0] * v[i][0] + v[i][1] * v[i][1] + v[i][2] * v[i][2] + v[i][3] * v[i][3];
#pragma unroll
        for (int o = 32; o >= 1; o >>= 1) ss += shx(ss, o, lane);
        const float rs = rsqrtf(ss * (1.f / 2048.f) + 1e-6f);
#pragma unroll
        for (int i = 0; i < 8; ++i) { const f32x4 y = v[i] * rs * am[i] + bm[i]; u32x2 w; w.x = cvtpk(y[0], y[1]); w.y = cvtpk(y[2], y[3]);
            *(u32x2*)(H + (size_t)t * DM + i * 256 + lane * 4) = w; }
#pragma unroll
        for (int i = 0; i < 8; ++i) v[i] = vn[i];
    }
#undef PN_SRC
}

DI void bpost(const Params& p) {
    int tid_ = threadIdx.x; asm volatile("" : "+v"(tid_));
    const int tid = tid_, G = gridDim.x, bid = blockIdx.x, i = tid & 31, ln = tid & 63;
    unsigned char* ws = p.ws; bf16_t* QK = (bf16_t*)(ws + WS_QKVG); bf16_t* OG = (bf16_t*)(ws + WS_H);
    const float lam = ((const float*)(ws + WS_MISC))[0];
    const f32x4 sb0 = *(const f32x4*)(p.in[20] + i * 8), sb1 = *(const f32x4*)(p.in[20] + i * 8 + 4);
    const int tstep = G * (NTHREADS / 32);
    u32x4 w1[4], w2[4], wg[4], n1[4], n2[4], ng[4];
#define BP_LD(A1, A2, AG, tt, hh0) do { _Pragma("unroll") for (int u = 0; u < 4; ++u) { const int _h = (hh0) + u;                   \
        A1[u] = *(const u32x4*)(OG + (size_t)(tt) * 2048 + _h * 256 + i * 8); A2[u] = *(const u32x4*)(QK + (size_t)(tt) * 8192 + _h * 256 + i * 8); \
        AG[u] = *(const u32x4*)(QK + (size_t)(tt) * 8192 + 6144 + _h * 256 + i * 8); } } while (0)
    int t = (bid * NTHREADS + tid) >> 5;
    if (t < MT) BP_LD(w1, w2, wg, t, 0);
    for (; t < MT; t += tstep) {
#pragma unroll 1
        for (int h0 = 0; h0 < 8; h0 += 4) {
            const int tn = (h0 == 0) ? t : t + tstep, hn = (h0 == 0) ? 4 : 0;
            if (tn < MT) BP_LD(n1, n2, ng, tn, hn);
#pragma unroll
            for (int u = 0; u < 4; ++u) { const int h = h0 + u;
                float d[8] = {bf_lo(w1[u].x) - lam * bf_lo(w2[u].x), bf_hi(w1[u].x) - lam * bf_hi(w2[u].x), bf_lo(w1[u].y) - lam * bf_lo(w2[u].y), bf_hi(w1[u].y) - lam * bf_hi(w2[u].y),
                              bf_lo(w1[u].z) - lam * bf_lo(w2[u].z), bf_hi(w1[u].z) - lam * bf_hi(w2[u].z), bf_lo(w1[u].w) - lam * bf_lo(w2[u].w), bf_hi(w1[u].w) - lam * bf_hi(w2[u].w)};
                const float g[8] = {bf_lo(wg[u].x), bf_hi(wg[u].x), bf_lo(wg[u].y), bf_hi(wg[u].y), bf_lo(wg[u].z), bf_hi(wg[u].z), bf_lo(wg[u].w), bf_hi(wg[u].w)};
                float ss = 0;
#pragma unroll
                for (int q = 0; q < 8; ++q) ss += d[q] * d[q];
                ss += shx(ss, 16, ln); ss += shx(ss, 8, ln); ss += shx(ss, 4, ln); ss += shx(ss, 2, ln); ss += shx(ss, 1, ln);
                const float rs = rsqrtf(ss * (1.f / 256.f) + 1e-6f) * (1.f - LINIT);
#pragma unroll
                for (int q = 0; q < 8; ++q) d[q] = d[q] * rs * (q < 4 ? sb0[q & 3] : sb1[q & 3]) * silu_f(g[q]);
                u32x4 wo; wo.x = cvtpk(d[0], d[1]); wo.y = cvtpk(d[2], d[3]); wo.z = cvtpk(d[4], d[5]); wo.w = cvtpk(d[6], d[7]);
                *(u32x4*)(OG + (size_t)t * 2048 + h * 256 + i * 8) = wo; }
#pragma unroll
            for (int u = 0; u < 4; ++u) { w1[u] = n1[u]; w2[u] = n2[u]; wg[u] = ng[u]; }
        }
    }
#undef BP_LD
}

DI void attn_phase(const Params& p, int kind, int jdx, LAS unsigned char* lds) {
    int tid_ = threadIdx.x; asm volatile("" : "+v"(tid_));
    const int G = gridDim.x, bid = blockIdx.x, tid = tid_;
    unsigned char* ws = p.ws; bf16_t* QK = (bf16_t*)(ws + WS_QKVG); bf16_t* OG = (bf16_t*)(ws + WS_H); const bf16_t* cb = (const bf16_t*)(ws + WS_CACHE);
    LAS float* rpbL = (LAS float*)(lds + RPB_OFF);
    const int nlat = (kind == 1) ? 1024 : 2048, nitems = (kind == 1) ? 1280 : 2560, npass = (kind == 1) ? 2 : 1;
    const long N = (kind == 0) ? 5120 : 8192;
#pragma unroll 1
    for (int it = bid; it < nitems; it += G) {
#pragma unroll 1
        for (int ps = 0; ps < npass; ++ps) {
            AttnArgs a; a.fuse = 0; a.subln = nullptr; a.lam = 0.f; a.ldq = N; a.ldg = N; a.ldo = 2048; a.has_sink = 0; a.sinkl2 = 0.f; a.out_mode = 0; a.r0 = 0; a.rbase = 0; a.mode = 0; a.qpos0 = 0; a.s1_start = 0; a.s1_max = 4032; a.n0 = 4; a.ld1 = N;
            __syncthreads();
            const bool lat = it < nlat;
            if (kind == 0) {
                int b, h; long row0;
                if (lat) { b = it >> 8; const int rem = it & 255, qb = rem >> 4; h = (rem & 3) * 4 + ((rem >> 2) & 1) * 2 + ((rem >> 3) & 1); row0 = M_CTX + b * 4096 + qb * 256;
                    a.K0 = cb + C_AK + ((size_t)(b * 2 + jdx) * 256) * 512 + (h >> 2) * 128; a.V0 = a.K0 + (C_AV - C_AK); a.ld0 = 512;
                    a.K1 = QK + (long)(M_CTX + b * 4096) * N + 2048 + (h >> 2) * 128; a.n1 = 8; a.s1_start = qb * 256 - 128; a.mode = 1; a.qpos0 = qb * 256; }
                else { const int id = it - 2048; b = id >> 4; h = (id & 3) * 4 + ((id >> 2) & 1) * 2 + ((id >> 3) & 1); row0 = b * 256;
                    a.K0 = QK + row0 * N + 2048 + (h >> 2) * 128; a.V0 = a.K0 + 512; a.ld0 = N; a.K1 = a.K0; a.n1 = 0; }
                a.V1 = a.K1 + 512; a.has_sink = 1; a.sinkl2 = p.in[17][jdx * 16 + h] * LOG2E;
                a.Q = QK + row0 * N + h * 128; a.O = OG + row0 * 2048 + h * 128; a.Gp = QK + row0 * N + 3072 + h * 128;
            } else if (kind == 1) {
                const int m = ps; int b, h; long row0, krow0;
                if (lat) { b = it >> 7; const int rem = it & 127, qb = rem >> 3; h = rem & 7; row0 = M_CTX + b * 4096 + qb * 256; krow0 = M_CTX + b * 4096; a.n1 = 64;
                    a.K0 = cb + C_BK + (size_t)b * 256 * 2048 + h * 256 + m * 128; a.V0 = cb + C_BV + (size_t)b * 256 * 2048 + h * 256; a.ld0 = 2048; }
                else { const int id = it - 1024; b = id >> 3; h = id & 7; row0 = b * 256; krow0 = row0; a.n1 = 0;
                    a.K0 = QK + row0 * N + 2048 + h * 256 + m * 128; a.V0 = QK + row0 * N + 4096 + h * 256; a.ld0 = N; }
                a.Q = QK + row0 * N + h * 256 + m * 128;
                a.K1 = QK + krow0 * N + 2048 + h * 256 + m * 128; a.V1 = QK + krow0 * N + 4096 + h * 256;
                a.out_mode = 1; a.Gp = QK + row0 * N + 6144 + h * 256; a.O = OG + row0 * 2048 + h * 256;
                a.fuse = m; a.subln = p.in[20]; a.lam = ((const float*)(ws + WS_MISC))[0];
                attn_body_b(a, lds);
                continue;
            } else {
                int b, h; long row0;
                if (lat) { b = it >> 8; const int rem = it & 255, qb = rem >> 4; h = rem & 15; row0 = M_CTX + b * 4096 + qb * 256;
                    for (int e = tid; e < 465; e += NTHREADS) rpbL[e] = p.in[22][h * 465 + e] * (1.f / SCALE);
                    a.K0 = cb + C_CK + (size_t)b * 256 * 2048 + h * 128; a.V0 = a.K0 + (C_CV - C_CK); a.ld0 = 2048;
                    a.K1 = QK + (long)(M_CTX + b * 4096) * N + 2048 + h * 128; a.n1 = 12;
                    a.r0 = qb * 4; a.rbase = min(max(qb * 4 - 4, 0), 52); a.s1_start = a.rbase * 64; a.mode = 2; }
                else { const int id = it - 2048; b = id >> 4; h = id & 15; row0 = b * 256;
                    a.K0 = QK + row0 * N + 2048 + h * 128; a.V0 = a.K0 + 2048; a.ld0 = N; a.K1 = a.K0; a.n1 = 0; }
                a.V1 = a.K1 + 2048;
                a.Q = QK + row0 * N + h * 128; a.O = OG + row0 * 2048 + h * 128; a.Gp = QK + row0 * N + 6144 + h * 128;
            }
            attn_body(a, lds);
        }
    }
}

#define XB_TMO      128
#define XB_XCNT(j)  (256  + 64 * (j))
#define XB_XSUB(j)  (1280 + 64 * (j))
#define XB_XGEN(j)  (2304 + 64 * (j))
#define XB_TOP      3328
#define XB_TOPGEN   3392
#define XCD_BAR_WORDS 3456
#define XB_SPIN_CAP (1u << 18)
DI unsigned xb_ld(unsigned* p)              { return __hip_atomic_load(p, __ATOMIC_RELAXED, __HIP_MEMORY_SCOPE_AGENT); }
DI unsigned xb_add(unsigned* p, unsigned v) { return __hip_atomic_fetch_add(p, v, __ATOMIC_RELAXED, __HIP_MEMORY_SCOPE_AGENT); }
DI unsigned xb_xcc_id() { return (unsigned)__builtin_amdgcn_s_getreg((3 << 11) | 20) & 0xFu; }
#define XB_SPIN(cond, bar) do { unsigned _sp = 0; while (cond) { __builtin_amdgcn_s_sleep(1); \
    if ((++_sp & 255u) == 0u) { if (xb_ld(&(bar)[XB_TMO])) break; if (_sp > XB_SPIN_CAP) { atomicAdd(&(bar)[XB_TMO], 1u); break; } } } } while (0)
DI void xcd_barrier_complete(unsigned* bar, unsigned x, unsigned& nloc, unsigned& nx) {
    const unsigned G = gridDim.x;
    unsigned sum, cnt, mine, sp = 0u;
    for (;;) {
        sum = 0u; cnt = 0u; mine = 0u;
#pragma unroll
        for (unsigned j = 0; j < 16; ++j) { const unsigned c = xb_ld(&bar[XB_XCNT(j)]); sum += c; cnt += (c > 0u) ? 1u : 0u; mine = (j == x) ? c : mine; }
        if (sum == G) break;
        __builtin_amdgcn_s_sleep(1);
        if ((++sp & 255u) == 0u) { if (xb_ld(&bar[XB_TMO])) break; if (sp > XB_SPIN_CAP) { atomicAdd(&bar[XB_TMO], 1u); break; } }
    }
    nloc = mine > 0u ? mine : 1u; nx = cnt > 0u ? cnt : 1u;
}
DI void xcd_barrier(unsigned* bar, volatile LAS unsigned* st) {
    asm volatile("s_waitcnt vmcnt(0)" ::: "memory");
    __syncthreads();
    if (threadIdx.x == 0) {
        const unsigned x = xb_xcc_id();
        __builtin_amdgcn_s_waitcnt(0);
        unsigned nloc = st[0], nx = st[1];
        if (nloc == 0u) { xcd_barrier_complete(bar, x, nloc, nx); st[0] = nloc; st[1] = nx; }
        const unsigned old = xb_add(&bar[XB_XSUB(x)], 1u);
        const unsigned gen = old / nloc;
        if (old + 1u == (gen + 1u) * nloc) {
            __builtin_amdgcn_fence(__ATOMIC_RELEASE, "agent");
            asm volatile("s_waitcnt vmcnt(0)" ::: "memory");
            const unsigned og = xb_add(&bar[XB_TOP], 1u);
            const unsigned tg = og / nx;
            if (og + 1u == (tg + 1u) * nx) xb_add(&bar[XB_TOPGEN], 1u);
            else XB_SPIN(xb_ld(&bar[XB_TOPGEN]) == tg, bar);
            __builtin_amdgcn_fence(__ATOMIC_ACQUIRE, "agent");
            xb_add(&bar[XB_XGEN(x)], 1u);
            asm volatile("s_waitcnt vmcnt(0)" ::: "memory");
        } else {
            XB_SPIN(xb_ld(&bar[XB_XGEN(x)]) == gen, bar);
            __builtin_amdgcn_fence(__ATOMIC_ACQUIRE, "agent");
            asm volatile("s_waitcnt vmcnt(0)" ::: "memory");
        }
    }
    __syncthreads();
}

__global__ void __launch_bounds__(NTHREADS, 2) fwd_megakernel(Params p) {
    extern __shared__ __attribute__((aligned(16))) unsigned char shm[];
    cg::grid_group grid = cg::this_grid();
    unsigned char* ws = p.ws;
    const int G = gridDim.x;
    volatile LAS unsigned* xst = (volatile LAS unsigned*)((LAS unsigned char*)shm + XB_ST_OFF);
    unsigned* xbar = (unsigned*)(ws + WS_BAR);
    if (threadIdx.x < 2) xst[threadIdx.x] = 0u;
    __syncthreads();
    if (threadIdx.x == 0) (void)xb_add(&xbar[XB_XCNT(xb_xcc_id())], 1u);
    phase0(p, (char*)shm);
    grid.sync();
    ada_reduce(p);
    xcd_barrier(xbar, xst);
#pragma unroll 1
    for (int l = 0; l < 4; ++l) {
        const int kind = l % 3, jdx = l / 3;
        prenorm(p, l);
        xcd_barrier(xbar, xst);
        {
            const bf16_t* Wt = (kind == 0) ? (const bf16_t*)(ws + WS_WTA) + (size_t)jdx * 5120 * 2048 : (kind == 1) ? (const bf16_t*)(ws + WS_WTB) : (const bf16_t*)(ws + WS_WTC);
            const int N = (kind == 0) ? 5120 : 8192;
            pg8::Gemm g{(const bf16_t*)(ws + WS_H), Wt, MT, N, DM}; pg8::StaticOrder S; S.init(MT, N, G, (int)blockIdx.x);
            pg8::EpiQKVG E{(bf16_t*)(ws + WS_QKVG), N, (kind == 0) ? 10 : 16, (kind == 0) ? 10 : 16, (kind == 0) ? 12 : 24, p.in[14] + l * 128, p.in[15] + l * 128,
                           (const float*)(ws + WS_ROPE), (kind != 2) ? 1 : 0, p.out + (kind == 0 ? O_AK : kind == 1 ? O_BK : O_CK), p.out + (kind == 0 ? O_AV : kind == 1 ? O_BV : O_CV), (kind == 0) ? 1 : 0, jdx};
            pg8::gemm_phase<pg8::EpiQKVG, pg8::StaticOrder>((LAS unsigned char*)shm, g, S, E);
        }
        xcd_barrier(xbar, xst);
        attn_phase(p, kind, jdx, (LAS unsigned char*)shm);
        xcd_barrier(xbar, xst);
        {
            pg8::Gemm g{(const bf16_t*)(ws + WS_H), (const bf16_t*)(ws + WS_WTO) + (size_t)l * 2048 * 2048, MT, DM, DM}; pg8::StaticOrder S; S.init(MT, DM, G, (int)blockIdx.x);
            pg8::EpiOut E{l == 0 ? p.in[0] : p.out, l == 0 ? p.in[1] : p.out + (size_t)M_CTX * DM, p.out, (const float*)(ws + WS_GATE) + (size_t)l * 9 * DM};
            pg8::gemm_phase<pg8::EpiOut, pg8::StaticOrder>((LAS unsigned char*)shm, g, S, E);
        }
        if (l < 3) xcd_barrier(xbar, xst);
    }
}

extern "C" void kernel_launch(void* const* d_in, const int* in_sizes, int n_in, void* d_out, int out_size, void* d_ws, size_t ws_size, hipStream_t stream) {
    static int grid_blocks = 0;
    if (grid_blocks == 0) {
        if (n_in != 23 || ws_size < WS_END) { fprintf(stderr, "kernel_launch: unexpected n_in %d or ws_size %zu (need %zu)\n", n_in, ws_size, (size_t)WS_END); grid_blocks = -1; return; }
        int dev = 0, cus = 0, per_cu = 0;
        hipGetDevice(&dev);
        hipDeviceGetAttribute(&cus, hipDeviceAttributeMultiprocessorCount, dev);
        if (hipFuncSetAttribute((const void*)fwd_megakernel, hipFuncAttributeMaxDynamicSharedMemorySize, LDS_BYTES) != hipSuccess) { fprintf(stderr, "kernel_launch: hipFuncSetAttribute failed\n"); grid_blocks = -1; return; }
        hipOccupancyMaxActiveBlocksPerMultiprocessor(&per_cu, (const void*)fwd_megakernel, NTHREADS, LDS_BYTES);
        if (per_cu < 1) { fprintf(stderr, "kernel_launch: occupancy query says %d blocks per CU\n", per_cu); per_cu = 1; }
        (void)hipGetLastError();
        grid_blocks = cus * 1;
    }
    if (grid_blocks < 0) return;
    if (hipMemsetAsync((char*)d_ws + WS_BAR, 0, XCD_BAR_WORDS * 4, stream) != hipSuccess) { fprintf(stderr, "kernel_launch: hipMemsetAsync of the barrier words failed\n"); return; }
    Params p{};
    for (int i = 0; i < 23; ++i) p.in[i] = (const float*)d_in[i];
    p.out = (float*)d_out; p.ws = (unsigned char*)d_ws;
    void* args[] = {&p};
    hipError_t e = hipLaunchCooperativeKernel((const void*)fwd_megakernel, dim3(grid_blocks), dim3(NTHREADS), args, LDS_BYTES, stream);
    if (e != hipSuccess) fprintf(stderr, "cooperative launch failed: %s (grid %d)\n", hipGetErrorString(e), grid_blocks);
}
```

```cpp
#include <hip/hip_runtime.h>
#include <hip/hip_cooperative_groups.h>
#include <cstdio>
#include <cstdint>
namespace cg = cooperative_groups;

#define DI __device__ __forceinline__
#define LAS __attribute__((address_space(3)))
typedef unsigned short bf16_t;
typedef short bf16x8 __attribute__((ext_vector_type(8)));
typedef short s16x4 __attribute__((ext_vector_type(4)));
typedef float f32x4 __attribute__((ext_vector_type(4)));
typedef float f32x16 __attribute__((ext_vector_type(16)));
typedef unsigned u32x4 __attribute__((ext_vector_type(4)));
typedef unsigned u32x2 __attribute__((ext_vector_type(2)));

constexpr int DM = 2048, M_CTX = 8192, M_LAT = 32768, MT = 40960;
constexpr float SCALE = 0.088388347648318440f;
constexpr float LOG2E = 1.4426950408889634f;
constexpr float LINIT = 0.35550906759f;
constexpr int NTHREADS = 512;
constexpr int XB_ST_OFF = 149504;
constexpr int LDS_BYTES = 149504 + 16;

constexpr size_t O_YP = 0, O_YS = 16777216, O_AK = 83886080, O_AV = 92274688, O_BK = 100663296, O_BV = 117440512, O_CK = 134217728, O_CV = 150994944;

constexpr size_t WS_WTA = 0;
constexpr size_t WS_WTB = WS_WTA + 41943040;
constexpr size_t WS_WTC = WS_WTB + 33554432;
constexpr size_t WS_WTO = WS_WTC + 33554432;
constexpr size_t WS_CACHE = WS_WTO + 33554432;
constexpr size_t WS_PART = WS_CACHE + 41943040;
constexpr size_t WS_MODA = WS_PART + 14155776;
constexpr size_t WS_MODB = WS_MODA + 294912;
constexpr size_t WS_GATE = WS_MODB + 294912;
constexpr size_t WS_ROPE = WS_GATE + 294912;
constexpr size_t WS_MISC = WS_ROPE + 16384;
constexpr size_t WS_H = WS_MISC + 4096;
constexpr size_t WS_QKVG = WS_H + 167772160;
constexpr size_t WS_BAR = WS_QKVG + 671088640;
constexpr size_t WS_END = WS_QKVG + 671088640 + 65536;
constexpr size_t C_AK = 0, C_AV = 2097152, C_BK = 4194304, C_BV = 8388608, C_CK = 12582912, C_CV = 16777216;

struct Params { const float* in[23]; float* out; unsigned char* ws; };

DI unsigned cvtpk(float lo, float hi) { unsigned r; asm volatile("v_cvt_pk_bf16_f32 %0, %1, %2" : "=v"(r) : "v"(lo), "v"(hi)); return r; }
DI float bf_lo(unsigned w) { return __uint_as_float(w << 16); }
DI float bf_hi(unsigned w) { return __uint_as_float(w & 0xffff0000u); }
DI float bf2f(bf16_t x) { return __uint_as_float((unsigned)x << 16); }
DI float silu_f(float g) { return g / (1.f + __expf(-g)); }
DI float shx(float v, int m, int lane) { return __int_as_float(__builtin_amdgcn_ds_bpermute((lane ^ m) << 2, __float_as_int(v))); }

DI int hd_phys(int e) { const int a = e >> 6, half = (e >> 5) & 1, f = e & 31, pi = 32 * a + f; return 8 * (pi >> 2) + 2 * (pi & 3) + half; }

namespace pg8 {
constexpr int BM = 256, BK = 64, HALF = 128, HTB = HALF * BK * 2, STAGE_BYTES = 8 * HTB, NXCD = 8, WGM = 8;
DI int lds_byte(int r, int c) { const int st = (r >> 4) * 2 + (c >> 5), rr = r & 15, cc = c & 31, ob = rr * 64 + cc * 2; return st * 1024 + (ob ^ (((ob >> 9) & 1) << 5)); }
DI void stage_rc(int b, int& R, int& C) { const int st = b / 1024, sb = b % 1024, swz = sb ^ (((sb >> 9) & 1) << 5); R = (st >> 1) * 16 + swz / 64; C = (st & 1) * 32 + (swz % 64) / 2; }
DI int perm32(int rho) { const int n = rho >> 4, i = rho & 15; return 8 * (i >> 2) + 4 * n + (i & 3); }
struct Unit { int pm, pn; };
struct Gemm { const bf16_t* A; const bf16_t* Bt; int M, N, K; };
struct StaticOrder {
    int nM, nN, nwg, G, c;
    DI void init(int M, int N, int G_, int c_) { nM = M / BM; nN = N / BM; nwg = nM * nN; G = G_; c = c_; }
    DI bool next(int i, Unit& u) const {
        const long L = (long)i * G + c; if (L >= nwg) return false;
        int wgid = (int)L; { const int q = nwg / NXCD, r = nwg % NXCD, xcd = wgid % NXCD, off = wgid / NXCD; wgid = (xcd < r ? xcd * (q + 1) : r * (q + 1) + (xcd - r) * q) + off; }
        const int nig = WGM * nN, gid = wgid / nig, fm = gid * WGM, gsz = (nM - fm) < WGM ? (nM - fm) : WGM;
        u.pm = fm + ((wgid % nig) % gsz); u.pn = (wgid % nig) / gsz; return true;
    }
};

struct EpiQKVG {
    static constexpr bool PERM = true;
    bf16_t* O; int ldc; int nqk, nv0, nv1; const float* qg; const float* kg; const float* cosT; int do_rope; float* kout; float* vout; int kindA, jdx;
    DI void operator()(const f32x4 (&acc)[2][2][4][2], const Unit& u, int wr, int wc, int fr, int fq, LAS unsigned char* lds) const {
        { int ln_; asm volatile("v_mbcnt_lo_u32_b32 %0, -1, 0\n\tv_mbcnt_hi_u32_b32 %0, -1, %0" : "=v"(ln_)); fr = ln_ & 15; fq = ln_ >> 4; }
        const int row0 = u.pm * BM + wr * 64 + fr; const int col0 = u.pn * BM + wc * 32 + 8 * fq;
        const bool ctx = u.pm < 32;
        if (u.pn >= nqk) {
            const bool vt = ctx && u.pn >= nv0 && u.pn < nv1;
#pragma unroll
            for (int ai = 0; ai < 2; ++ai)
#pragma unroll
                for (int m = 0; m < 4; ++m) { const int row = row0 + ai * HALF + m * 16; bf16_t* rowp = O + (size_t)row * ldc + col0;
#pragma unroll
                    for (int bj = 0; bj < 2; ++bj) { const f32x4 v0 = acc[ai][bj][m][0], v1 = acc[ai][bj][m][1];
                        u32x4 w; w.x = cvtpk(v0[0], v0[1]); w.y = cvtpk(v0[2], v0[3]); w.z = cvtpk(v1[0], v1[1]); w.w = cvtpk(v1[2], v1[3]);
                        *(u32x4*)(rowp + bj * HALF) = w;
                        if (vt) { const int vc = col0 + bj * HALF - nv0 * BM;
                            float* d = kindA ? vout + ((size_t)((u.pm * 2 + jdx) * 256 + (row & 255))) * 512 + vc : vout + (size_t)row * 2048 + vc;
                            *(f32x4*)d = v0; *(f32x4*)(d + 4) = v1; } } }
            return;
        }
        const int L = wc * 4 + fq, ax = L >> 3, f0 = (L & 7) * 4;
        const float* gs = (u.pn < 8) ? qg : kg;
        const f32x4 g0 = *(const f32x4*)(gs + 64 * ax + f0), g1 = *(const f32x4*)(gs + 64 * ax + 32 + f0);
        LAS float* part = (LAS float*)(lds + 131072);
#pragma unroll
        for (int ai = 0; ai < 2; ++ai)
#pragma unroll
            for (int m = 0; m < 4; ++m)
#pragma unroll
                for (int bj = 0; bj < 2; ++bj) { const f32x4 x0 = acc[ai][bj][m][0], x1 = acc[ai][bj][m][1];
                    float ss = x0[0] * x0[0] + x0[1] * x0[1] + x0[2] * x0[2] + x0[3] * x0[3] + x1[0] * x1[0] + x1[1] * x1[1] + x1[2] * x1[2] + x1[3] * x1[3];
                    ss += shx(ss, 16, fq * 16 + fr); ss += shx(ss, 32, fq * 16 + fr);
                    if (fq == 0) part[(((((wr * 2 + ai) * 4 + m) * 16 + fr) * 2 + bj) << 2) + wc] = ss; }
        asm volatile("s_waitcnt lgkmcnt(0)" ::: "memory"); __builtin_amdgcn_s_barrier(); asm volatile("" ::: "memory");
        const bool rope = (!ctx) && do_rope; const bool kt = ctx && u.pn >= 8;
        f32x4 cs[2][4], sn[2][4];
#pragma unroll
        for (int ai = 0; ai < 2; ++ai)
#pragma unroll
            for (int m = 0; m < 4; ++m) { cs[ai][m] = (f32x4){1.f, 1.f, 1.f, 1.f}; sn[ai][m] = (f32x4){0.f, 0.f, 0.f, 0.f};
                if (rope) { const int row = row0 + ai * HALF + m * 16; const int n = (row - M_CTX) & 4095; const int pos = ax ? (n & 63) : (n >> 6);
                    cs[ai][m] = *(const f32x4*)(cosT + pos * 32 + f0); sn[ai][m] = *(const f32x4*)(cosT + 2048 + pos * 32 + f0); } }
#pragma unroll
        for (int ai = 0; ai < 2; ++ai)
#pragma unroll
            for (int m = 0; m < 4; ++m) { const int row = row0 + ai * HALF + m * 16; bf16_t* rowp = O + (size_t)row * ldc + col0;
                const f32x4 c4 = cs[ai][m], s4 = sn[ai][m];
#pragma unroll
                for (int bj = 0; bj < 2; ++bj) { const f32x4 x0 = acc[ai][bj][m][0], x1 = acc[ai][bj][m][1];
                    const f32x4 pt = *(const LAS f32x4*)(part + (((((wr * 2 + ai) * 4 + m) * 16 + fr) * 2 + bj) << 2));
                    const float rs = rsqrtf((pt[0] + pt[1] + pt[2] + pt[3]) * (1.f / 128.f) + 1e-6f);
                    f32x4 h0 = {x0[0] * rs * g0[0], x0[2] * rs * g0[1], x1[0] * rs * g0[2], x1[2] * rs * g0[3]};
                    f32x4 h1 = {x0[1] * rs * g1[0], x0[3] * rs * g1[1], x1[1] * rs * g1[2], x1[3] * rs * g1[3]};
                    const f32x4 r0 = h0 * c4 - h1 * s4, r1 = h1 * c4 + h0 * s4;
                    u32x4 w; w.x = cvtpk(r0[0], r1[0]); w.y = cvtpk(r0[1], r1[1]); w.z = cvtpk(r0[2], r1[2]); w.w = cvtpk(r0[3], r1[3]);
                    *(u32x4*)(rowp + bj * HALF) = w;
                    if (kt) { const int hk = (u.pn - 8) * 2 + bj;
                        float* d = (kindA ? kout + ((size_t)((u.pm * 2 + jdx) * 256 + (row & 255))) * 512 : kout + (size_t)row * 2048) + hk * 128 + 64 * ax + f0;
                        *(f32x4*)d = r0; *(f32x4*)(d + 32) = r1; } } }
    }
};
struct EpiOut {
    static constexpr bool PERM = false;
    const float* xin_ctx; const float* xin_lat; float* out; const float* gate;
    DI void operator()(const f32x4 (&acc)[2][2][4][2], const Unit& u, int wr, int wc, int fr, int fq, LAS unsigned char*) const {
        const int row0 = u.pm * BM + wr * 64 + fr, col0 = u.pn * BM + wc * 32 + 4 * fq;
        const bool ctx = u.pm < 32; const int r9 = ctx ? 0 : 1 + ((u.pm - 32) >> 4);
        const float* xb = ctx ? xin_ctx : xin_lat; const int rsub = ctx ? 0 : M_CTX;
        f32x4 gv[2][2];
#pragma unroll
        for (int bj = 0; bj < 2; ++bj)
#pragma unroll
            for (int n = 0; n < 2; ++n) gv[bj][n] = *(const f32x4*)(gate + r9 * DM + col0 + bj * HALF + n * 16);
        f32x4 xr_[3][2][2];
#define EPO_LD(g, slot) do { const int _row = row0 + ((g) >> 2) * HALF + ((g) & 3) * 16; const float* _xr = xb + (size_t)(_row - rsub) * DM + col0;      \
        _Pragma("unroll") for (int bj = 0; bj < 2; ++bj) _Pragma("unroll") for (int n = 0; n < 2; ++n) xr_[slot][bj][n] = *(const f32x4*)(_xr + bj * HALF + n * 16); } while (0)
        EPO_LD(0, 0); EPO_LD(1, 1); EPO_LD(2, 2);
#pragma unroll
        for (int g = 0; g < 8; ++g) { const int ai = g >> 2, m = g & 3, slot = g % 3; const int row = row0 + ai * HALF + m * 16; float* orow = out + (size_t)row * DM + col0;
#pragma unroll
            for (int bj = 0; bj < 2; ++bj)
#pragma unroll
                for (int n = 0; n < 2; ++n) *(f32x4*)(orow + bj * HALF + n * 16) = xr_[slot][bj][n] + gv[bj][n] * acc[ai][bj][m][n];
            __builtin_amdgcn_sched_barrier(0);
            if (g + 3 < 8) { if (slot == 0) EPO_LD(g + 3, 0); else if (slot == 1) EPO_LD(g + 3, 1); else EPO_LD(g + 3, 2); }
            __builtin_amdgcn_sched_barrier(0); }
#undef EPO_LD
    }
};

template <class Epi, class Sched>
DI void gemm_phase(LAS unsigned char* lds, const Gemm g, const Sched& S, const Epi& E) {
    int tid_ = threadIdx.x; asm volatile("" : "+v"(tid_));
    const int tid = tid_, wid = __builtin_amdgcn_readfirstlane(tid >> 6), lane = tid & 63, wr = wid >> 2, wc = wid & 3, fr = lane & 15, fq = lane >> 4;
    const int K = g.K, nt = K / BK;
    unsigned voffA[2], voffB[2];
#pragma unroll
    for (int i = 0; i < 2; ++i) { int R, C; stage_rc(tid * 16 + i * 8192, R, C); const int Rb = Epi::PERM ? ((R & ~31) + perm32(R & 31)) : R;
        voffA[i] = (unsigned)(R * K + C) * 2u; voffB[i] = (unsigned)(Rb * K + C) * 2u; }
    const size_t kstep = (size_t)(BK * 2);
    const size_t hstep = (size_t)HALF * K * 2;
    const size_t tstep = 2 * hstep;
    const unsigned ldsw = (unsigned)wid * 1024u;
    const int aoff = lds_byte(wr * 64 + fr, fq * 8), boff = lds_byte(wc * 32 + fr, fq * 8);
#define PG8_SA(b, h) (((b) * 2 + (h)) * HTB)
#define PG8_SB(b, h) ((4 + (b) * 2 + (h)) * HTB)
#define PG8_STAGE(bufoff, gbase, voff) do { _Pragma("unroll") for (int _i = 0; _i < 2; ++_i) \
        __builtin_amdgcn_global_load_lds((const unsigned*)((const char*)(gbase) + (voff)[_i]), (LAS unsigned*)(lds + (bufoff) + ldsw + _i * 8192), 16, 0, 0); } while (0)
#define PG8_LDA(dst, b, h) do { _Pragma("unroll") for (int m = 0; m < 4; ++m) _Pragma("unroll") for (int k = 0; k < 2; ++k) dst[m][k] = *(const LAS bf16x8*)(lds + PG8_SA(b, h) + aoff + m * 2048 + k * 1024); } while (0)
#define PG8_LDB(dst, b, h) do { _Pragma("unroll") for (int n = 0; n < 2; ++n) _Pragma("unroll") for (int k = 0; k < 2; ++k) dst[n][k] = *(const LAS bf16x8*)(lds + PG8_SB(b, h) + boff + n * 2048 + k * 1024); } while (0)
#define PG8_MMA(ai, bj, At, Bt) do { __builtin_amdgcn_s_setprio(1); _Pragma("unroll") for (int m = 0; m < 4; ++m) _Pragma("unroll") for (int n = 0; n < 2; ++n) _Pragma("unroll") for (int k = 0; k < 2; ++k) \
        acc[ai][bj][m][n] = __builtin_amdgcn_mfma_f32_16x16x32_bf16(Bt[n][k], At[m][k], acc[ai][bj][m][n], 0, 0, 0); __builtin_amdgcn_s_setprio(0); } while (0)
#define PG8_WAIT_V(n) asm volatile("s_waitcnt vmcnt(" #n ")" ::: "memory")
#define PG8_WAIT_L(n) asm volatile("s_waitcnt lgkmcnt(" #n ")" ::: "memory")
#define PG8_BAR __builtin_amdgcn_s_barrier()
#define PG8_SCHED __builtin_amdgcn_sched_barrier(0)
    Unit cur, nxt; int ui = 0;
    if (!S.next(0, cur)) return;
    f32x4 acc[2][2][4][2];
#pragma unroll
    for (int a = 0; a < 2; ++a)
#pragma unroll
        for (int b = 0; b < 2; ++b)
#pragma unroll
            for (int m = 0; m < 4; ++m)
#pragma unroll
                for (int n = 0; n < 2; ++n) acc[a][b][m][n] = (f32x4){0.f, 0.f, 0.f, 0.f};
    bf16x8 At[4][2], B0[2][2], B1[2][2];
    const char* cA = (const char*)g.A + (size_t)cur.pm * tstep; const char* cB = (const char*)g.Bt + (size_t)cur.pn * tstep;
    PG8_STAGE(PG8_SB(0, 0), cB, voffB); PG8_STAGE(PG8_SA(0, 0), cA, voffA); PG8_STAGE(PG8_SB(0, 1), cB + hstep, voffB); PG8_STAGE(PG8_SA(0, 1), cA + hstep, voffA);
    if (wr == 1) PG8_BAR;
    PG8_WAIT_V(4); PG8_BAR;
    PG8_STAGE(PG8_SB(1, 0), cB + kstep, voffB); PG8_STAGE(PG8_SA(1, 0), cA + kstep, voffA); PG8_STAGE(PG8_SB(1, 1), cB + hstep + kstep, voffB);
    PG8_WAIT_V(6); PG8_BAR;
    for (;;) {
        const bool has_next = S.next(ui + 1, nxt);
        const char* nA = has_next ? (const char*)g.A + (size_t)nxt.pm * tstep : cA; const char* nB = has_next ? (const char*)g.Bt + (size_t)nxt.pn * tstep : cB;
        for (int t = 0; t < nt; t += 2) {
            const bool last = (t == nt - 2);
            const char* a1 = cA + (size_t)(t + 1) * kstep;
            const char* a2 = last ? nA : cA + (size_t)(t + 2) * kstep; const char* b2 = last ? nB : cB + (size_t)(t + 2) * kstep;
            const char* a3 = a2 + kstep; const char* b3 = b2 + kstep;
            PG8_LDB(B0, 0, 0); PG8_SCHED; PG8_LDA(At, 0, 0); PG8_STAGE(PG8_SA(1, 1), a1 + hstep, voffA);
            PG8_WAIT_L(8); PG8_BAR; PG8_WAIT_L(0); PG8_MMA(0, 0, At, B0); PG8_BAR; PG8_SCHED;
            PG8_LDB(B1, 0, 1); PG8_STAGE(PG8_SB(0, 0), b2, voffB);
            PG8_BAR; PG8_WAIT_L(0); PG8_MMA(0, 1, At, B1); PG8_BAR;
            PG8_LDA(At, 0, 1); PG8_STAGE(PG8_SA(0, 0), a2, voffA);
            PG8_BAR; PG8_WAIT_L(0); PG8_MMA(1, 0, At, B0); PG8_BAR; PG8_SCHED;
            PG8_STAGE(PG8_SB(0, 1), b2 + hstep, voffB);
            PG8_WAIT_V(6); PG8_BAR; PG8_MMA(1, 1, At, B1); PG8_BAR;
            PG8_LDB(B0, 1, 0); PG8_SCHED; PG8_LDA(At, 1, 0); PG8_STAGE(PG8_SA(0, 1), a2 + hstep, voffA);
            PG8_WAIT_L(8); PG8_BAR; PG8_WAIT_L(0); PG8_MMA(0, 0, At, B0); PG8_BAR; PG8_SCHED;
            PG8_LDB(B1, 1, 1); PG8_STAGE(PG8_SB(1, 0), b3, voffB);
            PG8_BAR; PG8_WAIT_L(0); PG8_MMA(0, 1, At, B1); PG8_BAR;
            PG8_LDA(At, 1, 1); PG8_STAGE(PG8_SA(1, 0), a3, voffA);
            PG8_BAR; PG8_WAIT_L(0); PG8_MMA(1, 0, At, B0); PG8_BAR; PG8_SCHED;
            PG8_STAGE(PG8_SB(1, 1), b3 + hstep, voffB);
            PG8_WAIT_V(6); PG8_BAR; PG8_MMA(1, 1, At, B1); PG8_BAR;
        }
        E(acc, cur, wr, wc, fr, fq, lds);
        if (!has_next) break;
#pragma unroll
        for (int a = 0; a < 2; ++a)
#pragma unroll
            for (int b = 0; b < 2; ++b)
#pragma unroll
                for (int m = 0; m < 4; ++m)
#pragma unroll
                    for (int n = 0; n < 2; ++n) acc[a][b][m][n] = (f32x4){0.f, 0.f, 0.f, 0.f};
        cur = nxt; cA = nA; cB = nB; ++ui;
    }
    PG8_WAIT_V(0);
    if (wr == 0) PG8_BAR;
    PG8_BAR;
#undef PG8_SA
#undef PG8_SB
#undef PG8_STAGE
#undef PG8_LDA
#undef PG8_LDB
#undef PG8_MMA
#undef PG8_WAIT_V
#undef PG8_WAIT_L
#undef PG8_BAR
#undef PG8_SCHED
}
}

constexpr float THR = 8.f;
constexpr int STG = 16384;
constexpr int KST_OFF = 0, VST_OFF = 65536, WSL_OFF = 131072, RPB_OFF = 133120;
#define KSWZ(row, colB) ((row) * 256 + ((colB) ^ (((row) & 7) << 4)))
#define SBAR() __builtin_amdgcn_sched_barrier(0)
DI int crow(int r, int hi) { return (r & 3) + 8 * (r >> 2) + 4 * hi; }

struct AttnArgs {
    const bf16_t* Q; long ldq;
    const bf16_t* K0; const bf16_t* V0; long ld0; int n0;
    const bf16_t* K1; const bf16_t* V1; long ld1; int n1; int s1_start, s1_max;
    int mode;
    int qpos0, r0, rbase;
    int has_sink; float sinkl2;
    int out_mode;
    bf16_t* O; long ldo; const bf16_t* Gp; long ldg;
    int fuse; const float* subln; float lam;
};

DI void apply_mask(f32x16& p0, f32x16& p1, const AttnArgs& a, int j, int wid, int r32, int hi, const LAS float* rpbL) {
    if (a.mode == 0 || j < a.n0) return;
    { int l2 = r32 | (hi << 5); asm volatile("" : "+v"(l2)); r32 = l2 & 31; hi = l2 >> 5; }
    const int jl = j - a.n0;
#ifndef ATT_NOMODE1
    if (a.mode == 1) {
        const int kbase = a.s1_start + jl * 64;
        const bool tv = (kbase >= 0) && (kbase < 4096);
        { const int qlo = a.qpos0 + wid * 32; if (tv && kbase >= qlo + 31 - 128 && kbase + 63 <= qlo + 128) return; }
        int dqh = tv ? (kbase - (a.qpos0 + wid * 32 + r32) + 4 * hi + 128) : 1000000;
        asm volatile("" : "+v"(dqh));
#pragma unroll
        for (int r = 0; r < 16; ++r) { const int cq = (r & 3) + 8 * (r >> 2);
            p0[r] = ((unsigned)(dqh + cq) <= 256u) ? p0[r] : -1e30f;
            p1[r] = ((unsigned)(dqh + cq + 32) <= 256u) ? p1[r] : -1e30f; }
    }
#else
    if (0) {}
#endif
#ifndef ATT_NOMODE2
    else {
        const int kr = a.rbase + jl, r = a.r0 + (wid >> 1); const int rs = min(max(r - 4, 0), 56);
        const bool tv = (kr >= rs) && (kr < rs + 8);
        if (!tv) {
#pragma unroll
            for (int q = 0; q < 16; ++q) { p0[q] = -1e30f; p1[q] = -1e30f; }
        } else {
            const int c = (wid & 1) * 32 + r32; const int cs = min(max(c - 8, 0), 48);
            int tq = 4 * hi - cs;
            int bidx = (kr - r + 7) * 31 + 15 - c + 4 * hi;
            asm volatile("" : "+v"(tq), "+v"(bidx));
            const LAS float* bp = rpbL + bidx;
#pragma unroll
            for (int q = 0; q < 16; ++q) { const int cq = (q & 3) + 8 * (q >> 2);
                const float b0 = bp[cq], b1 = bp[cq + 32];
                p0[q] = ((unsigned)(tq + cq) < 16u) ? p0[q] + b0 : -1e30f; p1[q] = ((unsigned)(tq + cq + 32) < 16u) ? p1[q] + b1 : -1e30f;
                if ((q & 3) == 3) SBAR(); }
        }
    }
#endif
}
DI bool tile_dead(const AttnArgs& a, int j, int wid) {
    if (a.mode == 0 || j < a.n0) return false;
    const int jl = j - a.n0;
    if (a.mode == 1) { const int kbase = a.s1_start + jl * 64, qlo = a.qpos0 + wid * 32;
        return !((kbase >= 0) && (kbase < 4096) && (kbase + 63 >= qlo - 128) && (kbase <= qlo + 31 + 128)); }
    const int kr = a.rbase + jl, r = a.r0 + (wid >> 1); const int rs = min(max(r - 4, 0), 56);
    return !((kr >= rs) && (kr < rs + 8));
}
DI void partialSM(f32x16& p0, f32x16& p1, float& m_reg, float& mn, float& alpha) {
    constexpr float C = SCALE * LOG2E;
    float pmax = p0[0];
#pragma unroll
    for (int r = 1; r < 16; ++r) pmax = fmaxf(pmax, p0[r]);
#pragma unroll
    for (int r = 0; r < 16; ++r) pmax = fmaxf(pmax, p1[r]);
    { auto rr = __builtin_amdgcn_permlane32_swap(__float_as_uint(pmax), __float_as_uint(pmax), false, false);
      pmax = fmaxf(__uint_as_float(rr[0]), __uint_as_float(rr[1])); }
    if (__builtin_expect(__all(pmax - m_reg <= THR / SCALE), 1)) { mn = m_reg; alpha = 1.f; }
    else { mn = fmaxf(m_reg, pmax); alpha = __builtin_amdgcn_exp2f((m_reg - mn) * C); m_reg = mn; }
    const float mnC = -mn * C;
#pragma unroll
    for (int r = 0; r < 16; ++r) p0[r] = fmaf(p0[r], C, mnC);
#pragma unroll
    for (int r = 0; r < 16; ++r) p1[r] = fmaf(p1[r], C, mnC);
#pragma unroll
    for (int r = 0; r < 16; ++r) p0[r] = __builtin_amdgcn_exp2f(p0[r]);
}
DI void finishSM(f32x16& p0, f32x16& p1, float alpha, float& l_reg, bf16x8& pa0, bf16x8& pa1, bf16x8& pa2, bf16x8& pa3) {
#pragma unroll
    for (int r = 0; r < 16; ++r) p1[r] = __builtin_amdgcn_exp2f(p1[r]);
    float ps = 0;
#pragma unroll
    for (int r = 0; r < 16; ++r) ps += p0[r];
#pragma unroll
    for (int r = 0; r < 16; ++r) ps += p1[r];
    { auto rr = __builtin_amdgcn_permlane32_swap(__float_as_uint(ps), __float_as_uint(ps), false, false);
      ps = __uint_as_float(rr[0]) + __uint_as_float(rr[1]); }
    l_reg = l_reg * alpha + ps;
#define PK4(P, BASE, OUT) do { unsigned a0 = cvtpk(P[BASE + 0], P[BASE + 1]), a1 = cvtpk(P[BASE + 2], P[BASE + 3]);   \
    unsigned b0 = cvtpk(P[BASE + 4], P[BASE + 5]), b1 = cvtpk(P[BASE + 6], P[BASE + 7]);                              \
    auto r0 = __builtin_amdgcn_permlane32_swap(a0, b0, false, false); auto r1 = __builtin_amdgcn_permlane32_swap(a1, b1, false, false); \
    u32x4 w = {r0[0], r1[0], r0[1], r1[1]}; OUT = *reinterpret_cast<bf16x8*>(&w); } while (0)
    PK4(p0, 0, pa0); PK4(p0, 8, pa1); PK4(p1, 0, pa2); PK4(p1, 8, pa3);
#undef PK4
}
DI void qkt(f32x16& p0, f32x16& p1, const LAS unsigned char* Ks, const bf16x8* qr, int r32, int hi) {
    p0 = f32x16{}; p1 = f32x16{};
    { int l2 = r32 | (hi << 5); asm volatile("" : "+v"(l2)); r32 = l2 & 31; hi = l2 >> 5; }
#pragma unroll
    for (int d0 = 0; d0 < 8; ++d0) { const int cb = (d0 * 16 + hi * 8) * 2;
        bf16x8 b0 = *reinterpret_cast<const LAS bf16x8*>(Ks + KSWZ(r32, cb));
        bf16x8 b1 = *reinterpret_cast<const LAS bf16x8*>(Ks + KSWZ(32 + r32, cb));
        p0 = __builtin_amdgcn_mfma_f32_32x32x16_bf16(b0, qr[d0], p0, 0, 0, 0);
        p1 = __builtin_amdgcn_mfma_f32_32x32x16_bf16(b1, qr[d0], p1, 0, 0, 0);
        if (d0 == 3) SBAR(); }
}
DI int v_st(int k, int c) { const int kk = (k & ~0xC) | ((k & 4) << 1) | ((k & 8) >> 1); return ((kk >> 3) * 4 + (c >> 5)) * 512 + ((kk & 7) * 32 + (c & 31)) * 2; }
DI int v_rd_base(int lane) { return ((lane & 3) << 3) | (((lane >> 2) & 3) << 6) | (((lane >> 4) & 1) << 5) | (((lane >> 5) & 1) << 8); }
constexpr int v_rd_off(int d0, int ks, int half) { return d0 * 512 + ks * 4096 + half * 2048; }
template <int OFF> DI s16x4 tr_read(int vb) {
    s16x4 r; asm volatile("ds_read_b64_tr_b16 %0, %1 offset:%2" : "=&v"(r) : "v"(vb), "i"(OFF) : "memory"); return r;
}
template <int D0> DI void pv_one(f32x16& od, int vb, bf16x8 pa0, bf16x8 pa1, bf16x8 pa2, bf16x8 pa3) {
    const s16x4 l0 = tr_read<v_rd_off(D0, 0, 0)>(vb), h0 = tr_read<v_rd_off(D0, 0, 1)>(vb), l1 = tr_read<v_rd_off(D0, 1, 0)>(vb), h1 = tr_read<v_rd_off(D0, 1, 1)>(vb);
    const s16x4 l2 = tr_read<v_rd_off(D0, 2, 0)>(vb), h2 = tr_read<v_rd_off(D0, 2, 1)>(vb), l3 = tr_read<v_rd_off(D0, 3, 0)>(vb), h3 = tr_read<v_rd_off(D0, 3, 1)>(vb);
    asm volatile("s_waitcnt lgkmcnt(0)" ::: "memory"); SBAR();
#define PK(L, H) (bf16x8){L[0], L[1], L[2], L[3], H[0], H[1], H[2], H[3]}
    od = __builtin_amdgcn_mfma_f32_32x32x16_bf16(pa0, PK(l0, h0), od, 0, 0, 0);
    od = __builtin_amdgcn_mfma_f32_32x32x16_bf16(pa1, PK(l1, h1), od, 0, 0, 0);
    od = __builtin_amdgcn_mfma_f32_32x32x16_bf16(pa2, PK(l2, h2), od, 0, 0, 0);
    od = __builtin_amdgcn_mfma_f32_32x32x16_bf16(pa3, PK(l3, h3), od, 0, 0, 0);
#undef PK
}
#define PV_RD(S, D0, VB) const s16x4 S##l0 = tr_read<v_rd_off(D0, 0, 0)>(VB), S##h0 = tr_read<v_rd_off(D0, 0, 1)>(VB), S##l1 = tr_read<v_rd_off(D0, 1, 0)>(VB), S##h1 = tr_read<v_rd_off(D0, 1, 1)>(VB), \
                               S##l2 = tr_read<v_rd_off(D0, 2, 0)>(VB), S##h2 = tr_read<v_rd_off(D0, 2, 1)>(VB), S##l3 = tr_read<v_rd_off(D0, 3, 0)>(VB), S##h3 = tr_read<v_rd_off(D0, 3, 1)>(VB)
#define PV_PK(L, H) (bf16x8){L[0], L[1], L[2], L[3], H[0], H[1], H[2], H[3]}
#define PV_MM(S, OD) do { OD = __builtin_amdgcn_mfma_f32_32x32x16_bf16(pa0, PV_PK(S##l0, S##h0), OD, 0, 0, 0); OD = __builtin_amdgcn_mfma_f32_32x32x16_bf16(pa1, PV_PK(S##l1, S##h1), OD, 0, 0, 0); \
                          OD = __builtin_amdgcn_mfma_f32_32x32x16_bf16(pa2, PV_PK(S##l2, S##h2), OD, 0, 0, 0); OD = __builtin_amdgcn_mfma_f32_32x32x16_bf16(pa3, PV_PK(S##l3, S##h3), OD, 0, 0, 0); } while (0)
#define PV_W8() do { asm volatile("s_waitcnt lgkmcnt(8)" ::: "memory"); SBAR(); } while (0)
#define PV_W0() do { asm volatile("s_waitcnt lgkmcnt(0)" ::: "memory"); SBAR(); } while (0)
template <int NH> DI void pv_pipe(f32x16* o, int vb, bf16x8 pa0, bf16x8 pa1, bf16x8 pa2, bf16x8 pa3) {
    SBAR();
    { PV_RD(a, 0, vb); SBAR();
      { PV_RD(b, 1, vb); PV_W8(); PV_MM(a, o[0]); SBAR();
        { PV_RD(c, 2, vb); PV_W8(); PV_MM(b, o[1]); SBAR();
          { PV_RD(d, 3, vb); PV_W8(); PV_MM(c, o[2]); SBAR();
            if constexpr (NH == 1) { PV_W0(); PV_MM(d, o[3]); SBAR(); }
            else { const int vb2 = vb + STG;
              { PV_RD(e, 0, vb2); PV_W8(); PV_MM(d, o[3]); SBAR();
                { PV_RD(f, 1, vb2); PV_W8(); PV_MM(e, o[4]); SBAR();
                  { PV_RD(g, 2, vb2); PV_W8(); PV_MM(f, o[5]); SBAR();
                    { PV_RD(h, 3, vb2); PV_W8(); PV_MM(g, o[6]); SBAR();
                      PV_W0(); PV_MM(h, o[7]); SBAR(); } } } } } } } } }
}
DI void pv_d0(f32x16* o, int vb, bf16x8 pa0, bf16x8 pa1, bf16x8 pa2, bf16x8 pa3) { pv_pipe<1>(o, vb, pa0, pa1, pa2, pa3); }

DI void attn_body(const AttnArgs& a, LAS unsigned char* lds) {
    int tid_ = threadIdx.x; asm volatile("" : "+v"(tid_));
    const int tid = tid_, wid = __builtin_amdgcn_readfirstlane(tid >> 6), lane = tid & 63, r32 = lane & 31, hi = lane >> 5;
    LAS unsigned char* Kst = lds + KST_OFF; LAS unsigned char* Vst = lds + VST_OFF;
    LAS float* wsl = (LAS float*)(lds + WSL_OFF) + wid * 64; LAS float* li_l = wsl; LAS float* al_l = wsl + 32;
    const LAS float* rpbL = (const LAS float*)(lds + RPB_OFF);
    float m_reg = -1e30f, l_reg = 0; f32x16 o[4] = {}; bf16x8 qr[8];
    const bf16_t* Qw = a.Q + (long)(wid * 32 + r32) * a.ldq + hi * 8;
#pragma unroll
    for (int d0 = 0; d0 < 8; ++d0) qr[d0] = *reinterpret_cast<const bf16x8*>(Qw + d0 * 16);
    const int vb0 = (int)(size_t)Vst + v_rd_base(lane);
#define ISSUE(jt, ST) do { const int _j = (jt); const char* _k; const char* _v; unsigned _ld;                                   \
    if (_j < a.n0) { _ld = (unsigned)a.ld0 * 2u; const size_t _o = (size_t)_j * 64 * _ld; _k = (const char*)a.K0 + _o; _v = (const char*)a.V0 + _o; }                         \
    else { int _st = a.s1_start + (_j - a.n0) * 64; _st = max(0, min(_st, a.s1_max)); _ld = (unsigned)a.ld1 * 2u; const size_t _o = (size_t)_st * _ld; _k = (const char*)a.K1 + _o; _v = (const char*)a.V1 + _o; } \
    unsigned _ln = (unsigned)lane; asm volatile("" : "+v"(_ln));                                                                  \
    _Pragma("unroll") for (int _i = 0; _i < 2; ++_i) { const unsigned _s = (unsigned)((wid * 2 + _i) * 64) + _ln;                 \
        const unsigned _rk = _s >> 4, _ck = ((_s & 15u) << 4) ^ ((_rk & 7u) << 4);                                                \
        const unsigned _sub = _s >> 5, _w5 = _s & 31u, _kk = (_sub >> 2) * 8u + (_w5 >> 2);                                         \
        const unsigned _rv = (_kk & ~0xCu) | ((_kk & 4u) << 1) | ((_kk & 8u) >> 1), _cv = ((_sub & 3u) * 32u + (_w5 & 3u) * 8u) * 2u; \
        unsigned _ok = _rk * _ld + _ck, _ov = _rv * _ld + _cv; asm volatile("" : "+v"(_ok), "+v"(_ov));                           \
        __builtin_amdgcn_global_load_lds((const unsigned*)(_k + _ok), (LAS unsigned*)(Kst + (ST) * STG + (wid * 2 + _i) * 1024), 16, 0, 0); \
        __builtin_amdgcn_global_load_lds((const unsigned*)(_v + _ov), (LAS unsigned*)(Vst + (ST) * STG + (wid * 2 + _i) * 1024), 16, 0, 0); } } while (0)
#define WAITV(n) asm volatile("s_waitcnt vmcnt(" #n ")" ::: "memory")
#define BAR() do { asm volatile("s_waitcnt lgkmcnt(0)" ::: "memory"); __builtin_amdgcn_s_barrier(); asm volatile("" ::: "memory"); SBAR(); } while (0)
#define RESC(al) do { if (__any((al) < 1.f)) { if (hi == 0) al_l[r32] = (al); asm volatile("s_waitcnt lgkmcnt(0)" ::: "memory"); \
    _Pragma("unroll") for (int d = 0; d < 4; ++d) _Pragma("unroll") for (int r = 0; r < 16; ++r) o[d][r] *= al_l[crow(r, hi)]; } } while (0)
    f32x16 pA0, pA1, pB0, pB1; float mnA, mnB, alA, alB; bf16x8 pa0, pa1, pa2, pa3; const int NT = a.n0 + a.n1;
#define STEP(X0, X1, mnX, alX, deadX, Y0, Y1, alY, deadY, jt, KS, VS) do { const int _jj = (jt);                                    \
    deadX = tile_dead(a, _jj, wid);                                                                                               \
    SBAR(); if (!deadX) qkt(X0, X1, Kst + (KS) * STG, qr, r32, hi);                                                               \
    else { _Pragma("unroll") for (int _q = 0; _q < 16; ++_q) { X0[_q] = -1e30f; X1[_q] = -1e30f; } }                              \
    SBAR();                                                                                                                       \
    if (!deadY) finishSM(Y0, Y1, alY, l_reg, pa0, pa1, pa2, pa3);                                                                 \
    SBAR();                                                                                                                       \
    if (_jj + 2 < NT) ISSUE(_jj + 2, ((KS) + 2) & 3);                                                                             \
    SBAR();                                                                                                                       \
    if (!deadY) pv_d0(o, vb0 + (VS) * STG, pa0, pa1, pa2, pa3);                                                                   \
    SBAR(); if (!deadX) { apply_mask(X0, X1, a, _jj, wid, r32, hi, rpbL); SBAR(); partialSM(X0, X1, m_reg, mnX, alX); RESC(alX); } \
    if (_jj + 2 < NT) WAITV(4); else WAITV(0);                                                                                    \
    BAR(); } while (0)
    bool deadA = false, deadB = false;
    ISSUE(0, 0); ISSUE(1, 1);
    WAITV(4); BAR();
    SBAR(); qkt(pA0, pA1, Kst, qr, r32, hi); SBAR();
    ISSUE(2, 2);
    SBAR(); apply_mask(pA0, pA1, a, 0, wid, r32, hi, rpbL); partialSM(pA0, pA1, m_reg, mnA, alA);
    WAITV(4); BAR();
#pragma unroll 1
    for (int j = 1; j < NT; j += 4) {
        STEP(pB0, pB1, mnB, alB, deadB, pA0, pA1, alA, deadA, j, 1, 0);
        STEP(pA0, pA1, mnA, alA, deadA, pB0, pB1, alB, deadB, j + 1, 2, 1);
        STEP(pB0, pB1, mnB, alB, deadB, pA0, pA1, alA, deadA, j + 2, 3, 2);
        if (j + 3 < NT) STEP(pA0, pA1, mnA, alA, deadA, pB0, pB1, alB, deadB, j + 3, 0, 3);
    }
    if (!deadB) { finishSM(pB0, pB1, alB, l_reg, pa0, pa1, pa2, pa3); SBAR();
        pv_d0(o, vb0 + 3 * STG, pa0, pa1, pa2, pa3); }
    if (a.has_sink) l_reg += __builtin_amdgcn_exp2f(a.sinkl2 - m_reg * (SCALE * LOG2E));
    if (hi == 0) li_l[r32] = l_reg; asm volatile("s_waitcnt lgkmcnt(0)" ::: "memory");
    float rli[16];
#pragma unroll
    for (int r = 0; r < 16; ++r) rli[r] = __builtin_amdgcn_rcpf(li_l[crow(r, hi)]);
    {
        int wu = wid; unsigned rl = (unsigned)r32 * 2u;
        asm volatile("" : "+s"(wu), "+v"(rl));
        char* Ow = (char*)(a.O + (size_t)(wu * 32) * a.ldo); const char* Gw = (const char*)(a.Gp + (size_t)(wu * 32) * a.ldg);
        const unsigned ldo2 = (unsigned)a.ldo * 2u, ldg2 = (unsigned)a.ldg * 2u;
        if (a.out_mode == 0) {
            BAR();
            unsigned ln = (unsigned)lane; asm volatile("" : "+v"(ln));
            u32x4 gw[8];
#pragma unroll
            for (int i = 0; i < 8; ++i) { const unsigned c = (unsigned)i * 64u + ln; gw[i] = *(const u32x4*)(Gw + (c >> 4) * ldg2 + (c & 15u) * 16u); }
            LAS float* img = (LAS float*)(lds + (unsigned)wu * 16384u);
            const unsigned wbase = (unsigned)hi * 4u * 128u + (ln & 31u);
#pragma unroll
            for (int r = 0; r < 16; ++r) { const unsigned ro = wbase + (unsigned)((r & 3) + 8 * (r >> 2)) * 128u;
                img[ro] = o[0][r] * rli[r]; img[ro + 32] = o[1][r] * rli[r]; img[ro + 64] = o[2][r] * rli[r]; img[ro + 96] = o[3][r] * rli[r]; }
            asm volatile("s_waitcnt lgkmcnt(0)" ::: "memory");
#pragma unroll
            for (int i = 0; i < 8; ++i) { const unsigned c = (unsigned)i * 64u + ln; const unsigned row = c >> 4, c8 = (c & 15u) * 8u;
                const f32x4 x0 = *(const LAS f32x4*)(img + row * 128u + c8), x1 = *(const LAS f32x4*)(img + row * 128u + c8 + 4);
                const u32x4 g = gw[i]; u32x4 w;
                w.x = cvtpk(x0[0] * silu_f(bf_lo(g.x)), x0[1] * silu_f(bf_hi(g.x))); w.y = cvtpk(x0[2] * silu_f(bf_lo(g.y)), x0[3] * silu_f(bf_hi(g.y)));
                w.z = cvtpk(x1[0] * silu_f(bf_lo(g.z)), x1[1] * silu_f(bf_hi(g.z))); w.w = cvtpk(x1[2] * silu_f(bf_lo(g.w)), x1[3] * silu_f(bf_hi(g.w)));
                *(u32x4*)(Ow + row * ldo2 + c8 * 2u) = w; }
        } else {
#pragma unroll
            for (int r = 0; r < 16; ++r) { const unsigned orow = (unsigned)crow(r, hi); const unsigned oo = orow * ldo2 + rl;
                const float v0 = o[0][r] * rli[r], v1 = o[1][r] * rli[r], v2 = o[2][r] * rli[r], v3 = o[3][r] * rli[r];
                *(bf16_t*)(Ow + oo) = (bf16_t)(cvtpk(v0, 0.f) & 0xffffu); *(bf16_t*)(Ow + oo + 64) = (bf16_t)(cvtpk(v1, 0.f) & 0xffffu);
                *(bf16_t*)(Ow + oo + 128) = (bf16_t)(cvtpk(v2, 0.f) & 0xffffu); *(bf16_t*)(Ow + oo + 192) = (bf16_t)(cvtpk(v3, 0.f) & 0xffffu); }
        }
    }
#undef ISSUE
#undef WAITV
#undef BAR
#undef RESC
#undef STEP
}

constexpr int BK_OFF = 0, BV_OFF = 49152, BWSL_OFF = 147456;
DI void attn_body_b(const AttnArgs& a, LAS unsigned char* lds) {
    int tid_ = threadIdx.x; asm volatile("" : "+v"(tid_));
    const int tid = tid_, wid = __builtin_amdgcn_readfirstlane(tid >> 6), lane = tid & 63, r32 = lane & 31, hi = lane >> 5;
    LAS unsigned char* Kst = lds + BK_OFF; LAS unsigned char* Vst = lds + BV_OFF;
    LAS float* wsl = (LAS float*)(lds + BWSL_OFF) + wid * 64; LAS float* li_l = wsl; LAS float* al_l = wsl + 32;
    float m_reg = -1e30f, l_reg = 0; f32x16 o[8] = {}; bf16x8 qr[8];
    const bf16_t* Qw = a.Q + (long)(wid * 32 + r32) * a.ldq + hi * 8;
#pragma unroll
    for (int d0 = 0; d0 < 8; ++d0) qr[d0] = *reinterpret_cast<const bf16x8*>(Qw + d0 * 16);
    const int vb0 = (int)(size_t)Vst + v_rd_base(lane);
#define ISSUEB(jt, ST) do { const int _j = (jt); const char* _k; const char* _v; unsigned _ld;                                   \
    if (_j < a.n0) { _ld = (unsigned)a.ld0 * 2u; const size_t _o = (size_t)_j * 64 * _ld; _k = (const char*)a.K0 + _o; _v = (const char*)a.V0 + _o; }                         \
    else { int _st = a.s1_start + (_j - a.n0) * 64; _st = max(0, min(_st, a.s1_max)); _ld = (unsigned)a.ld1 * 2u; const size_t _o = (size_t)_st * _ld; _k = (const char*)a.K1 + _o; _v = (const char*)a.V1 + _o; } \
    unsigned _ln = (unsigned)lane; asm volatile("" : "+v"(_ln));                                                                  \
    _Pragma("unroll") for (int _i = 0; _i < 2; ++_i) { const unsigned _s = (unsigned)((wid * 2 + _i) * 64) + _ln;                 \
        const unsigned _rk = _s >> 4, _ck = ((_s & 15u) << 4) ^ ((_rk & 7u) << 4);                                                \
        const unsigned _sub = _s >> 5, _w5 = _s & 31u, _kk = (_sub >> 2) * 8u + (_w5 >> 2);                                         \
        const unsigned _rv = (_kk & ~0xCu) | ((_kk & 4u) << 1) | ((_kk & 8u) >> 1), _cv = ((_sub & 3u) * 32u + (_w5 & 3u) * 8u) * 2u; \
        unsigned _ok = _rk * _ld + _ck, _ov = _rv * _ld + _cv; asm volatile("" : "+v"(_ok), "+v"(_ov));                           \
        __builtin_amdgcn_global_load_lds((const unsigned*)(_k + _ok), (LAS unsigned*)(Kst + (ST) * STG + (wid * 2 + _i) * 1024), 16, 0, 0); \
        __builtin_amdgcn_global_load_lds((const unsigned*)(_v + _ov), (LAS unsigned*)(Vst + (ST) * 2 * STG + (wid * 2 + _i) * 1024), 16, 0, 0); \
        __builtin_amdgcn_global_load_lds((const unsigned*)(_v + 256 + _ov), (LAS unsigned*)(Vst + (ST) * 2 * STG + STG + (wid * 2 + _i) * 1024), 16, 0, 0); } } while (0)
#define WAITV(n) asm volatile("s_waitcnt vmcnt(" #n ")" ::: "memory")
#define BAR() do { asm volatile("s_waitcnt lgkmcnt(0)" ::: "memory"); __builtin_amdgcn_s_barrier(); asm volatile("" ::: "memory"); SBAR(); } while (0)
    const int NT = a.n0 + a.n1;
    ISSUEB(0, 0);
    int st = 0;
#pragma unroll 1
    for (int j = 0; j < NT; ++j) {
        const int stn = (st == 2) ? 0 : st + 1;
        if (j + 1 < NT) { ISSUEB(j + 1, stn); WAITV(6); } else WAITV(0);
        BAR();
        f32x16 p0, p1; float mn, alpha; bf16x8 pa0, pa1, pa2, pa3;
        qkt(p0, p1, Kst + st * STG, qr, r32, hi); SBAR();
        partialSM(p0, p1, m_reg, mn, alpha);
        finishSM(p0, p1, alpha, l_reg, pa0, pa1, pa2, pa3); SBAR();
        if (__any(alpha < 1.f)) { if (hi == 0) al_l[r32] = alpha; asm volatile("s_waitcnt lgkmcnt(0)" ::: "memory");
#pragma unroll
            for (int d = 0; d < 8; ++d)
#pragma unroll
                for (int r = 0; r < 16; ++r) o[d][r] *= al_l[crow(r, hi)]; }
        SBAR();
        const int vb = vb0 + st * 2 * STG;
        pv_pipe<2>(o, vb, pa0, pa1, pa2, pa3);
        st = stn;
    }
    if (hi == 0) li_l[r32] = l_reg;
    BAR();
    {
        int wu = wid; unsigned ln = (unsigned)lane;
        asm volatile("" : "+s"(wu), "+v"(ln));
        char* Ow = (char*)(a.O + (size_t)(wu * 32) * a.ldo); const unsigned ldo2 = (unsigned)a.ldo * 2u;
        LAS unsigned char* img = lds + (unsigned)wu * 16384u;
        const unsigned wb = (ln >> 5) * 4u * 512u + (ln & 31u) * 2u;
#pragma unroll
        for (int r = 0; r < 16; ++r) { const float rli = __builtin_amdgcn_rcpf(li_l[crow(r, hi)]); const unsigned ro = wb + (unsigned)((r & 3) + 8 * (r >> 2)) * 512u;
#pragma unroll
            for (int d = 0; d < 8; ++d) *(LAS bf16_t*)(img + ro + d * 64) = (bf16_t)(cvtpk(o[d][r] * rli, 0.f) & 0xffffu); }
        asm volatile("s_waitcnt lgkmcnt(0)" ::: "memory");
        if (!a.fuse) {
#pragma unroll
            for (int i = 0; i < 16; ++i) { const unsigned c = (unsigned)i * 64u + ln; const unsigned row = c >> 5, ch = (c & 31u) * 16u;
                *(u32x4*)(Ow + row * ldo2 + ch) = *(const LAS u32x4*)(img + row * 512u + ch); }
        } else {
            const char* Gw = (const char*)(a.Gp + (size_t)(wu * 32) * a.ldg); const unsigned ldg2 = (unsigned)a.ldg * 2u;
            const float lam = a.lam; const unsigned cc = (ln & 31u) * 8u;
            const f32x4 sb0 = *(const f32x4*)(a.subln + cc), sb1 = *(const f32x4*)(a.subln + cc + 4);
#pragma unroll 1
            for (int i0 = 0; i0 < 16; i0 += 8) {
                u32x4 w1[8], wg[8];
#pragma unroll
                for (int u = 0; u < 8; ++u) { const unsigned c = (unsigned)(i0 + u) * 64u + ln; const unsigned row = c >> 5, ch = (c & 31u) * 16u;
                    w1[u] = *(const u32x4*)(Ow + row * ldo2 + ch); wg[u] = *(const u32x4*)(Gw + row * ldg2 + ch); }
#pragma unroll
                for (int u = 0; u < 8; ++u) { const unsigned c = (unsigned)(i0 + u) * 64u + ln; const unsigned row = c >> 5, ch = (c & 31u) * 16u;
                    const u32x4 w2 = *(const LAS u32x4*)(img + row * 512u + ch);
                    float d[8] = {bf_lo(w1[u].x) - lam * bf_lo(w2.x), bf_hi(w1[u].x) - lam * bf_hi(w2.x), bf_lo(w1[u].y) - lam * bf_lo(w2.y), bf_hi(w1[u].y) - lam * bf_hi(w2.y),
                                  bf_lo(w1[u].z) - lam * bf_lo(w2.z), bf_hi(w1[u].z) - lam * bf_hi(w2.z), bf_lo(w1[u].w) - lam * bf_lo(w2.w), bf_hi(w1[u].w) - lam * bf_hi(w2.w)};
                    const float g[8] = {bf_lo(wg[u].x), bf_hi(wg[u].x), bf_lo(wg[u].y), bf_hi(wg[u].y), bf_lo(wg[u].z), bf_hi(wg[u].z), bf_lo(wg[u].w), bf_hi(wg[u].w)};
                    float ss = 0;
#pragma unroll
                    for (int q = 0; q < 8; ++q) ss += d[q] * d[q];
                    ss += shx(ss, 16, (int)ln); ss += shx(ss, 8, (int)ln); ss += shx(ss, 4, (int)ln); ss += shx(ss, 2, (int)ln); ss += shx(ss, 1, (int)ln);
                    const float rs = rsqrtf(ss * (1.f / 256.f) + 1e-6f) * (1.f - LINIT);
#pragma unroll
                    for (int q = 0; q < 8; ++q) d[q] = d[q] * rs * (q < 4 ? sb0[q & 3] : sb1[q & 3]) * silu_f(g[q]);
                    u32x4 wo; wo.x = cvtpk(d[0], d[1]); wo.y = cvtpk(d[2], d[3]); wo.z = cvtpk(d[4], d[5]); wo.w = cvtpk(d[6], d[7]);
                    *(u32x4*)(Ow + row * ldo2 + ch) = wo; }
            }
        }
    }
    BAR();
#undef ISSUEB
#undef WAITV
#undef BAR
}

DI void cvt_array(const float* src, bf16_t* dst, long n, int bid, int G, int tid) {
    for (long i = ((long)bid * NTHREADS + tid) * 8; i < n; i += (long)G * NTHREADS * 8) {
        const f32x4 a = *(const f32x4*)(src + i), b = *(const f32x4*)(src + i + 4);
        u32x4 w; w.x = cvtpk(a[0], a[1]); w.y = cvtpk(a[2], a[3]); w.z = cvtpk(b[0], b[1]); w.w = cvtpk(b[2], b[3]);
        *(u32x4*)(dst + i) = w;
    }
}

DI void cvt_array_perm(const float* src, bf16_t* dst, long n, int bid, int G, int tid) {
    for (long i = ((long)bid * NTHREADS + tid) * 8; i < n; i += (long)G * NTHREADS * 8) {
        const long vb = i & ~127L; const int L = (int)(i & 127) >> 3, ax = L >> 3, f0 = (L & 7) * 4;
        const f32x4 a = *(const f32x4*)(src + vb + 64 * ax + f0), b = *(const f32x4*)(src + vb + 64 * ax + 32 + f0);
        u32x4 w; w.x = cvtpk(a[0], b[0]); w.y = cvtpk(a[1], b[1]); w.z = cvtpk(a[2], b[2]); w.w = cvtpk(a[3], b[3]);
        *(u32x4*)(dst + i) = w;
    }
}

DI void phase0(const Params& p, char* lds) {
    int tid_ = threadIdx.x; asm volatile("" : "+v"(tid_));
    const int tid = tid_, G = gridDim.x, bid = blockIdx.x;
    unsigned char* ws = p.ws;
    float* T = (float*)lds;
    for (int it = bid; it < 17408; it += G) {
        const int ct = it >> 5, kt = it & 31;
        const float* src; bf16_t* dst; int N, n0; int qklim = 0;
        if (ct < 160) { const int jj = ct / 80; N = 5120; qklim = 2560; n0 = (ct % 80) * 64; src = p.in[16] + (size_t)jj * 2048 * 5120; dst = (bf16_t*)(ws + WS_WTA) + (size_t)jj * 5120 * 2048; }
        else if (ct < 288) { N = 8192; qklim = 4096; n0 = (ct - 160) * 64; src = p.in[18]; dst = (bf16_t*)(ws + WS_WTB); }
        else if (ct < 416) { N = 8192; qklim = 4096; n0 = (ct - 288) * 64; src = p.in[21]; dst = (bf16_t*)(ws + WS_WTC); }
        else { const int jj = (ct - 416) >> 5; N = 2048; n0 = ((ct - 416) & 31) * 64; src = p.in[13] + (size_t)jj * 2048 * 2048; dst = (bf16_t*)(ws + WS_WTO) + (size_t)jj * 2048 * 2048; }
        const int k0 = kt * 64;
        __syncthreads();
#pragma unroll
        for (int i = 0; i < 2; ++i) { const int k = (tid >> 4) + 32 * i, n4 = (tid & 15) * 4;
            const f32x4 v = *(const f32x4*)(src + (size_t)(k0 + k) * N + n0 + n4);
            T[k * 65 + n4 + 0] = v[0]; T[k * 65 + n4 + 1] = v[1]; T[k * 65 + n4 + 2] = v[2]; T[k * 65 + n4 + 3] = v[3]; }
        __syncthreads();
        { const int n = tid >> 3, k8 = (tid & 7) * 8; u32x4 w;
          w.x = cvtpk(T[(k8 + 0) * 65 + n], T[(k8 + 1) * 65 + n]); w.y = cvtpk(T[(k8 + 2) * 65 + n], T[(k8 + 3) * 65 + n]);
          w.z = cvtpk(T[(k8 + 4) * 65 + n], T[(k8 + 5) * 65 + n]); w.w = cvtpk(T[(k8 + 6) * 65 + n], T[(k8 + 7) * 65 + n]);
          int nn = n0 + n; if (nn < qklim) nn = (nn & ~127) + hd_phys(nn & 127);
          *(u32x4*)(dst + (size_t)nn * 2048 + k0 + k8) = w; }
    }
    bf16_t* cb = (bf16_t*)(ws + WS_CACHE);
    cvt_array_perm(p.in[2], cb + C_AK, 2097152, bid, G, tid); cvt_array(p.in[3], cb + C_AV, 2097152, bid, G, tid);
    cvt_array_perm(p.in[4], cb + C_BK, 4194304, bid, G, tid); cvt_array(p.in[5], cb + C_BV, 4194304, bid, G, tid);
    cvt_array_perm(p.in[6], cb + C_CK, 4194304, bid, G, tid); cvt_array(p.in[7], cb + C_CV, 4194304, bid, G, tid);
    float* scl = (float*)lds + 8192;
    float* part = (float*)(ws + WS_PART);
    for (int it = bid; it < 768; it += G) {
        const int l = it / 192, rem = it % 192, cc = rem >> 4, kc = rem & 15;
        __syncthreads();
        for (int e = tid; e < 9 * 128; e += NTHREADS) { const int r = e >> 7, k = e & 127;
            const float cv = (r == 0) ? p.in[9][kc * 128 + k] : p.in[8][(r - 1) * 2048 + kc * 128 + k]; scl[e] = silu_f(cv); }
        __syncthreads();
        const float* W = p.in[11] + ((size_t)l * 2048 + kc * 128) * 6144 + cc * 512 + tid;
        float a0 = 0, a1 = 0, a2 = 0, a3 = 0, a4 = 0, a5 = 0, a6 = 0, a7 = 0, a8 = 0;
#pragma unroll 8
        for (int k = 0; k < 128; ++k) { const float w = W[(size_t)k * 6144];
            a0 += scl[k] * w; a1 += scl[128 + k] * w; a2 += scl[256 + k] * w; a3 += scl[384 + k] * w; a4 += scl[512 + k] * w;
            a5 += scl[640 + k] * w; a6 += scl[768 + k] * w; a7 += scl[896 + k] * w; a8 += scl[1024 + k] * w; }
        float* po = part + ((size_t)(l * 16 + kc) * 9) * 6144 + cc * 512 + tid;
        po[0] = a0; po[6144] = a1; po[2 * 6144] = a2; po[3 * 6144] = a3; po[4 * 6144] = a4; po[5 * 6144] = a5; po[6 * 6144] = a6; po[7 * 6144] = a7; po[8 * 6144] = a8;
    }
    if (bid == G - 1) {
        float* ct = (float*)(ws + WS_ROPE); float* st = ct + 2048;
        for (int e = tid; e < 2048; e += NTHREADS) { const int pos = e >> 5, f = e & 31;
            double inv = 1.0; for (int q = 0; q < f; ++q) inv *= 0.74989420933245582730;
            const float invf = (float)inv; const float angf = (float)pos * invf;
            double x = (double)angf; const double twopi = 6.283185307179586476925;
            const double kq = __builtin_rint(x / twopi); x -= kq * twopi;
            const double x2 = x * x; double sn = x, cs = 1.0, ts = x, tc = 1.0;
            for (int q = 1; q <= 12; ++q) { tc *= -x2 / (double)((2 * q - 1) * (2 * q)); cs += tc; ts *= -x2 / (double)((2 * q) * (2 * q + 1)); sn += ts; }
            ct[e] = (float)cs; st[e] = (float)sn; }
    }
}

DI void ada_reduce(const Params& p) {
    int tid_ = threadIdx.x; asm volatile("" : "+v"(tid_));
    const int tid = tid_, G = gridDim.x, bid = blockIdx.x;
    unsigned char* ws = p.ws;
    const float* part = (const float*)(ws + WS_PART);
    float* modA = (float*)(ws + WS_MODA); float* modB = (float*)(ws + WS_MODB); float* gate = (float*)(ws + WS_GATE);
    for (int e = bid * NTHREADS + tid; e < 4 * 9 * 6144; e += G * NTHREADS) {
        const int j = e % 6144, lr = e / 6144, l = lr / 9, r = lr % 9;
        float m = p.in[12][l * 6144 + j];
#pragma unroll
        for (int kc = 0; kc < 16; ++kc) m += part[((size_t)(l * 16 + kc) * 9 + r) * 6144 + j];
        if (j < 2048) modB[lr * 2048 + j] = m;
        else if (j < 4096) modA[lr * 2048 + j - 2048] = p.in[10][l * 2048 + j - 2048] * (1.f + m);
        else gate[lr * 2048 + j - 4096] = m;
    }
    if (bid == 0 && tid < 64) {
        const float* lam = p.in[19]; float s1 = 0, s2 = 0;
        for (int k = tid; k < 128; k += 64) { s1 += lam[k] * lam[128 + k]; s2 += lam[256 + k] * lam[384 + k]; }
#pragma unroll
        for (int o = 32; o >= 1; o >>= 1) { s1 += shx(s1, o, tid); s2 += shx(s2, o, tid); }
        if (tid == 0) ((float*)(ws + WS_MISC))[0] = expf(s1) - expf(s2) + LINIT;
    }
}

DI void prenorm(const Params& p, int l) {
    int tid_ = threadIdx.x; asm volatile("" : "+v"(tid_));
    const int tid = tid_, G = gridDim.x, bid = blockIdx.x, wid = tid >> 6, lane = tid & 63;
    unsigned char* ws = p.ws; bf16_t* H = (bf16_t*)(ws + WS_H);
    f32x4 v[8], vn[8];
    int t = bid * 8 + wid;
#define PN_SRC(tt) ((l == 0) ? ((tt) < M_CTX ? p.in[0] + (size_t)(tt) * DM : p.in[1] + (size_t)((tt) - M_CTX) * DM) : p.out + (size_t)(tt) * DM)
    if (t < MT) { const float* x = PN_SRC(t);
#pragma unroll
        for (int i = 0; i < 8; ++i) v[i] = *(const f32x4*)(x + i * 256 + lane * 4); }
    for (; t < MT; t += G * 8) {
        const int tn = t + G * 8;
        if (tn < MT) { const float* xn = PN_SRC(tn);
#pragma unroll
            for (int i = 0; i < 8; ++i) vn[i] = *(const f32x4*)(xn + i * 256 + lane * 4); }
        const int r9 = t < M_CTX ? 0 : 1 + ((t - M_CTX) >> 12);
        const float* A = (const float*)(ws + WS_MODA) + (l * 9 + r9) * DM; const float* B = (const float*)(ws + WS_MODB) + (l * 9 + r9) * DM;
        f32x4 am[8], bm[8];
#pragma unroll
        for (int i = 0; i < 8; ++i) { am[i] = *(const f32x4*)(A + i * 256 + lane * 4); bm[i] = *(const f32x4*)(B + i * 256 + lane * 4); }
        float ss = 0;
#pragma unroll
        for (int i = 0; i < 8; ++i) ss += v[i][0] * v[i][0] + v[i][1] * v[i][1] + v[i][2] * v[i][2] + v[i][3] * v[i][3];
#pragma unroll
        for (int o = 32; o >= 1; o >>= 1) ss += shx(ss, o, lane);
        const float rs = rsqrtf(ss * (1.f / 2048.f) + 1e-6f);
#pragma unroll
        for (int i = 0; i < 8; ++i) { const f32x4 y = v[i] * rs * am[i] + bm[i]; u32x2 w; w.x = cvtpk(y[0], y[1]); w.y = cvtpk(y[2], y[3]);
            *(u32x2*)(H + (size_t)t * DM + i * 256 + lane * 4) = w; }
#pragma unroll
        for (int i = 0; i < 8; ++i) v[i] = vn[i];
    }
#undef PN_SRC
}

DI void bpost(const Params& p) {
    int tid_ = threadIdx.x; asm volatile("" : "+v"(tid_));
    const int tid = tid_, G = gridDim.x, bid = blockIdx.x, i = tid & 31, ln = tid & 63;
    unsigned char* ws = p.ws; bf16_t* QK = (bf16_t*)(ws + WS_QKVG); bf16_t* OG = (bf16_t*)(ws + WS_H);
    const float lam = ((const float*)(ws + WS_MISC))[0];
    const f32x4 sb0 = *(const f32x4*)(p.in[20] + i * 8), sb1 = *(const f32x4*)(p.in[20] + i * 8 + 4);
    const int tstep = G * (NTHREADS / 32);
    u32x4 w1[4], w2[4], wg[4], n1[4], n2[4], ng[4];
#define BP_LD(A1, A2, AG, tt, hh0) do { _Pragma("unroll") for (int u = 0; u < 4; ++u) { const int _h = (hh0) + u;                   \
        A1[u] = *(const u32x4*)(OG + (size_t)(tt) * 2048 + _h * 256 + i * 8); A2[u] = *(const u32x4*)(QK + (size_t)(tt) * 8192 + _h * 256 + i * 8); \
        AG[u] = *(const u32x4*)(QK + (size_t)(tt) * 8192 + 6144 + _h * 256 + i * 8); } } while (0)
    int t = (bid * NTHREADS + tid) >> 5;
    if (t < MT) BP_LD(w1, w2, wg, t, 0);
    for (; t < MT; t += tstep) {
#pragma unroll 1
        for (int h0 = 0; h0 < 8; h0 += 4) {
            const int tn = (h0 == 0) ? t : t + tstep, hn = (h0 == 0) ? 4 : 0;
            if (tn < MT) BP_LD(n1, n2, ng, tn, hn);
#pragma unroll
            for (int u = 0; u < 4; ++u) { const int h = h0 + u;
                float d[8] = {bf_lo(w1[u].x) - lam * bf_lo(w2[u].x), bf_hi(w1[u].x) - lam * bf_hi(w2[u].x), bf_lo(w1[u].y) - lam * bf_lo(w2[u].y), bf_hi(w1[u].y) - lam * bf_hi(w2[u].y),
                              bf_lo(w1[u].z) - lam * bf_lo(w2[u].z), bf_hi(w1[u].z) - lam * bf_hi(w2[u].z), bf_lo(w1[u].w) - lam * bf_lo(w2[u].w), bf_hi(w1[u].w) - lam * bf_hi(w2[u].w)};
                const float g[8] = {bf_lo(wg[u].x), bf_hi(wg[u].x), bf_lo(wg[u].y), bf_hi(wg[u].y), bf_lo(wg[u].z), bf_hi(wg[u].z), bf_lo(wg[u].w), bf_hi(wg[u].w)};
                float ss = 0;
#pragma unroll
                for (int q = 0; q < 8; ++q) ss += d[q] * d[q];
                ss += shx(ss, 16, ln); ss += shx(ss, 8, ln); ss += shx(ss, 4, ln); ss += shx(ss, 2, ln); ss += shx(ss, 1, ln);
                const float rs = rsqrtf(ss * (1.f / 256.f) + 1e-6f) * (1.f - LINIT);
#pragma unroll
                for (int q = 0; q < 8; ++q) d[q] = d[q] * rs * (q < 4 ? sb0[q & 3] : sb1[q & 3]) * silu_f(g[q]);
                u32x4 wo; wo.x = cvtpk(d[0], d[1]); wo.y = cvtpk(d[2], d[3]); wo.z = cvtpk(d[4], d[5]); wo.w = cvtpk(d[6], d[7]);
                *(u32x4*)(OG + (size_t)t * 2048 + h * 256 + i * 8) = wo; }
#pragma unroll
            for (int u = 0; u < 4; ++u) { w1[u] = n1[u]; w2[u] = n2[u]; wg[u] = ng[u]; }
        }
    }
#undef BP_LD
}

DI void attn_phase(const Params& p, int kind, int jdx, LAS unsigned char* lds) {
    int tid_ = threadIdx.x; asm volatile("" : "+v"(tid_));
    const int G = gridDim.x, bid = blockIdx.x, tid = tid_;
    unsigned char* ws = p.ws; bf16_t* QK = (bf16_t*)(ws + WS_QKVG); bf16_t* OG = (bf16_t*)(ws + WS_H); const bf16_t* cb = (const bf16_t*)(ws + WS_CACHE);
    LAS float* rpbL = (LAS float*)(lds + RPB_OFF);
    const int nlat = (kind == 1) ? 1024 : 2048, nitems = (kind == 1) ? 1280 : 2560, npass = (kind == 1) ? 2 : 1;
    const long N = (kind == 0) ? 5120 : 8192;
#pragma unroll 1
    for (int it = bid; it < nitems; it += G) {
#pragma unroll 1
        for (int ps = 0; ps < npass; ++ps) {
            AttnArgs a; a.fuse = 0; a.subln = nullptr; a.lam = 0.f; a.ldq = N; a.ldg = N; a.ldo = 2048; a.has_sink = 0; a.sinkl2 = 0.f; a.out_mode = 0; a.r0 = 0; a.rbase = 0; a.mode = 0; a.qpos0 = 0; a.s1_start = 0; a.s1_max = 4032; a.n0 = 4; a.ld1 = N;
            __syncthreads();
            const bool lat = it < nlat;
            if (kind == 0) {
                int b, h; long row0;
                if (lat) { b = it >> 8; const int rem = it & 255, qb = rem >> 4; h = (rem & 3) * 4 + ((rem >> 2) & 1) * 2 + ((rem >> 3) & 1); row0 = M_CTX + b * 4096 + qb * 256;
                    a.K0 = cb + C_AK + ((size_t)(b * 2 + jdx) * 256) * 512 + (h >> 2) * 128; a.V0 = a.K0 + (C_AV - C_AK); a.ld0 = 512;
                    a.K1 = QK + (long)(M_CTX + b * 4096) * N + 2048 + (h >> 2) * 128; a.n1 = 8; a.s1_start = qb * 256 - 128; a.mode = 1; a.qpos0 = qb * 256; }
                else { const int id = it - 2048; b = id >> 4; h = (id & 3) * 4 + ((id >> 2) & 1) * 2 + ((id >> 3) & 1); row0 = b * 256;
                    a.K0 = QK + row0 * N + 2048 + (h >> 2) * 128; a.V0 = a.K0 + 512; a.ld0 = N; a.K1 = a.K0; a.n1 = 0; }
                a.V1 = a.K1 + 512; a.has_sink = 1; a.sinkl2 = p.in[17][jdx * 16 + h] * LOG2E;
                a.Q = QK + row0 * N + h * 128; a.O = OG + row0 * 2048 + h * 128; a.Gp = QK + row0 * N + 3072 + h * 128;
            } else if (kind == 1) {
                const int m = ps; int b, h; long row0, krow0;
                if (lat) { b = it >> 7; const int rem = it & 127, qb = rem >> 3; h = rem & 7; row0 = M_CTX + b * 4096 + qb * 256; krow0 = M_CTX + b * 4096; a.n1 = 64;
                    a.K0 = cb + C_BK + (size_t)b * 256 * 2048 + h * 256 + m * 128; a.V0 = cb + C_BV + (size_t)b * 256 * 2048 + h * 256; a.ld0 = 2048; }
                else { const int id = it - 1024; b = id >> 3; h = id & 7; row0 = b * 256; krow0 = row0; a.n1 = 0;
                    a.K0 = QK + row0 * N + 2048 + h * 256 + m * 128; a.V0 = QK + row0 * N + 4096 + h * 256; a.ld0 = N; }
                a.Q = QK + row0 * N + h * 256 + m * 128;
                a.K1 = QK + krow0 * N + 2048 + h * 256 + m * 128; a.V1 = QK + krow0 * N + 4096 + h * 256;
                a.out_mode = 1; a.Gp = QK + row0 * N + 6144 + h * 256; a.O = OG + row0 * 2048 + h * 256;
                a.fuse = m; a.subln = p.in[20]; a.lam = ((const float*)(ws + WS_MISC))[0];
                attn_body_b(a, lds);
                continue;
            } else {
                int b, h; long row0;
                if (lat) { b = it >> 8; const int rem = it & 255, qb = rem >> 4; h = rem & 15; row0 = M_CTX + b * 4096 + qb * 256;
                    for (int e = tid; e < 465; e += NTHREADS) rpbL[e] = p.in[22][h * 465 + e] * (1.f / SCALE);
                    a.K0 = cb + C_CK + (size_t)b * 256 * 2048 + h * 128; a.V0 = a.K0 + (C_CV - C_CK); a.ld0 = 2048;
                    a.K1 = QK + (long)(M_CTX + b * 4096) * N + 2048 + h * 128; a.n1 = 12;
                    a.r0 = qb * 4; a.rbase = min(max(qb * 4 - 4, 0), 52); a.s1_start = a.rbase * 64; a.mode = 2; }
                else { const int id = it - 2048; b = id >> 4; h = id & 15; row0 = b * 256;
                    a.K0 = QK + row0 * N + 2048 + h * 128; a.V0 = a.K0 + 2048; a.ld0 = N; a.K1 = a.K0; a.n1 = 0; }
                a.V1 = a.K1 + 2048;
                a.Q = QK + row0 * N + h * 128; a.O = OG + row0 * 2048 + h * 128; a.Gp = QK + row0 * N + 6144 + h * 128;
            }
            attn_body(a, lds);
        }
    }
}

#define XB_TMO      128
#define XB_XCNT(j)  (256  + 64 * (j))
#define XB_XSUB(j)  (1280 + 64 * (j))
#define XB_XGEN(j)  (2304 + 64 * (j))
#define XB_TOP      3328
#define XB_TOPGEN   3392
#define XCD_BAR_WORDS 3456
#define XB_SPIN_CAP (1u << 18)
DI unsigned xb_ld(unsigned* p)              { return __hip_atomic_load(p, __ATOMIC_RELAXED, __HIP_MEMORY_SCOPE_AGENT); }
DI unsigned xb_add(unsigned* p, unsigned v) { return __hip_atomic_fetch_add(p, v, __ATOMIC_RELAXED, __HIP_MEMORY_SCOPE_AGENT); }
DI unsigned xb_xcc_id() { return (unsigned)__builtin_amdgcn_s_getreg((3 << 11) | 20) & 0xFu; }
#define XB_SPIN(cond, bar) do { unsigned _sp = 0; while (cond) { __builtin_amdgcn_s_sleep(1); \
    if ((++_sp & 255u) == 0u) { if (xb_ld(&(bar)[XB_TMO])) break; if (_sp > XB_SPIN_CAP) { atomicAdd(&(bar)[XB_TMO], 1u); break; } } } } while (0)
DI void xcd_barrier_complete(unsigned* bar, unsigned x, unsigned& nloc, unsigned& nx) {
    const unsigned G = gridDim.x;
    unsigned sum, cnt, mine, sp = 0u;
    for (;;) {
        sum = 0u; cnt = 0u; mine = 0u;
#pragma unroll
        for (unsigned j = 0; j < 16; ++j) { const unsigned c = xb_ld(&bar[XB_XCNT(j)]); sum += c; cnt += (c > 0u) ? 1u : 0u; mine = (j == x) ? c : mine; }
        if (sum == G) break;
        __builtin_amdgcn_s_sleep(1);
        if ((++sp & 255u) == 0u) { if (xb_ld(&bar[XB_TMO])) break; if (sp > XB_SPIN_CAP) { atomicAdd(&bar[XB_TMO], 1u); break; } }
    }
    nloc = mine > 0u ? mine : 1u; nx = cnt > 0u ? cnt : 1u;
}
DI void xcd_barrier(unsigned* bar, volatile LAS unsigned* st) {
    asm volatile("s_waitcnt vmcnt(0)" ::: "memory");
    __syncthreads();
    if (threadIdx.x == 0) {
        const unsigned x = xb_xcc_id();
        __builtin_amdgcn_s_waitcnt(0);
        unsigned nloc = st[0], nx = st[1];
        if (nloc == 0u) { xcd_barrier_complete(bar, x, nloc, nx); st[0] = nloc; st[1] = nx; }
        const unsigned old = xb_add(&bar[XB_XSUB(x)], 1u);
        const unsigned gen = old / nloc;
        if (old + 1u == (gen + 1u) * nloc) {
            __builtin_amdgcn_fence(__ATOMIC_RELEASE, "agent");
            asm volatile("s_waitcnt vmcnt(0)" ::: "memory");
            const unsigned og = xb_add(&bar[XB_TOP], 1u);
            const unsigned tg = og / nx;
            if (og + 1u == (tg + 1u) * nx) xb_add(&bar[XB_TOPGEN], 1u);
            else XB_SPIN(xb_ld(&bar[XB_TOPGEN]) == tg, bar);
            __builtin_amdgcn_fence(__ATOMIC_ACQUIRE, "agent");
            xb_add(&bar[XB_XGEN(x)], 1u);
            asm volatile("s_waitcnt vmcnt(0)" ::: "memory");
        } else {
            XB_SPIN(xb_ld(&bar[XB_XGEN(x)]) == gen, bar);
            __builtin_amdgcn_fence(__ATOMIC_ACQUIRE, "agent");
            asm volatile("s_waitcnt vmcnt(0)" ::: "memory");
        }
    }
    __syncthreads();
}

__global__ void __launch_bounds__(NTHREADS, 2) fwd_megakernel(Params p) {
    extern __shared__ __attribute__((aligned(16))) unsigned char shm[];
    cg::grid_group grid = cg::this_grid();
    unsigned char* ws = p.ws;
    const int G = gridDim.x;
    volatile LAS unsigned* xst = (volatile LAS unsigned*)((LAS unsigned char*)shm + XB_ST_OFF);
    unsigned* xbar = (unsigned*)(ws + WS_BAR);
    if (threadIdx.x < 2) xst[threadIdx.x] = 0u;
    __syncthreads();
    if (threadIdx.x == 0) (void)xb_add(&xbar[XB_XCNT(xb_xcc_id())], 1u);
    phase0(p, (char*)shm);
    grid.sync();
    ada_reduce(p);
    xcd_barrier(xbar, xst);
#pragma unroll 1
    for (int l = 0; l < 4; ++l) {
        const int kind = l % 3, jdx = l / 3;
        prenorm(p, l);
        xcd_barrier(xbar, xst);
        {
            const bf16_t* Wt = (kind == 0) ? (const bf16_t*)(ws + WS_WTA) + (size_t)jdx * 5120 * 2048 : (kind == 1) ? (const bf16_t*)(ws + WS_WTB) : (const bf16_t*)(ws + WS_WTC);
            const int N = (kind == 0) ? 5120 : 8192;
            pg8::Gemm g{(const bf16_t*)(ws + WS_H), Wt, MT, N, DM}; pg8::StaticOrder S; S.init(MT, N, G, (int)blockIdx.x);
            pg8::EpiQKVG E{(bf16_t*)(ws + WS_QKVG), N, (kind == 0) ? 10 : 16, (kind == 0) ? 10 : 16, (kind == 0) ? 12 : 24, p.in[14] + l * 128, p.in[15] + l * 128,
                           (const float*)(ws + WS_ROPE), (kind != 2) ? 1 : 0, p.out + (kind == 0 ? O_AK : kind == 1 ? O_BK : O_CK), p.out + (kind == 0 ? O_AV : kind == 1 ? O_BV : O_CV), (kind == 0) ? 1 : 0, jdx};
            pg8::gemm_phase<pg8::EpiQKVG, pg8::StaticOrder>((LAS unsigned char*)shm, g, S, E);
        }
        xcd_barrier(xbar, xst);
        attn_phase(p, kind, jdx, (LAS unsigned char*)shm);
        xcd_barrier(xbar, xst);
        {
            pg8::Gemm g{(const bf16_t*)(ws + WS_H), (const bf16_t*)(ws + WS_WTO) + (size_t)l * 2048 * 2048, MT, DM, DM}; pg8::StaticOrder S; S.init(MT, DM, G, (int)blockIdx.x);
            pg8::EpiOut E{l == 0 ? p.in[0] : p.out, l == 0 ? p.in[1] : p.out + (size_t)M_CTX * DM, p.out, (const float*)(ws + WS_GATE) + (size_t)l * 9 * DM};
            pg8::gemm_phase<pg8::EpiOut, pg8::StaticOrder>((LAS unsigned char*)shm, g, S, E);
        }
        if (l < 3) xcd_barrier(xbar, xst);
    }
}

extern "C" void kernel_launch(void* const* d_in, const int* in_sizes, int n_in, void* d_out, int out_size, void* d_ws, size_t ws_size, hipStream_t stream) {
    static int grid_blocks = 0;
    if (grid_blocks == 0) {
        if (n_in != 23 || ws_size < WS_END) { fprintf(stderr, "kernel_launch: unexpected n_in %d or ws_size %zu (need %zu)\n", n_in, ws_size, (size_t)WS_END); grid_blocks = -1; return; }
        int dev = 0, cus = 0, per_cu = 0;
        hipGetDevice(&dev);
        hipDeviceGetAttribute(&cus, hipDeviceAttributeMultiprocessorCount, dev);
        if (hipFuncSetAttribute((const void*)fwd_megakernel, hipFuncAttributeMaxDynamicSharedMemorySize, LDS_BYTES) != hipSuccess) { fprintf(stderr, "kernel_launch: hipFuncSetAttribute failed\n"); grid_blocks = -1; return; }
        hipOccupancyMaxActiveBlocksPerMultiprocessor(&per_cu, (const void*)fwd_megakernel, NTHREADS, LDS_BYTES);
        if (per_cu < 1) { fprintf(stderr, "kernel_launch: occupancy query says %d blocks per CU\n", per_cu); per_cu = 1; }
        (void)hipGetLastError();
        grid_blocks = cus * 1;
    }
    if (grid_blocks < 0) return;
    if (hipMemsetAsync((char*)d_ws + WS_BAR, 0, XCD_BAR_WORDS * 4, stream) != hipSuccess) { fprintf(stderr, "kernel_launch: hipMemsetAsync of the barrier words failed\n"); return; }
    Params p{};
    for (int i = 0; i < 23; ++i) p.in[i] = (const float*)d_in[i];
    p.out = (float*)d_out; p.ws = (unsigned char*)d_ws;
    void* args[] = {&p};
    hipError_t e = hipLaunchCooperativeKernel((const void*)fwd_megakernel, dim3(grid_blocks), dim3(NTHREADS), args, LDS_BYTES, stream);
    if (e != hipSuccess) fprintf(stderr, "cooperative launch failed: %s (grid %d)\n", hipGetErrorString(e), grid_blocks);
}
```

```cpp
#include <hip/hip_runtime.h>
#include <hip/hip_cooperative_groups.h>
#include <cstdio>
#include <cstdint>
namespace cg = cooperative_groups;

#define DI __device__ __forceinline__
#define LAS __attribute__((address_space(3)))
typedef unsigned short bf16_t;
typedef short bf16x8 __attribute__((ext_vector_type(8)));
typedef short s16x4 __attribute__((ext_vector_type(4)));
typedef float f32x4 __attribute__((ext_vector_type(4)));
typedef float f32x16 __attribute__((ext_vector_type(16)));
typedef unsigned u32x4 __attribute__((ext_vector_type(4)));
typedef unsigned u32x2 __attribute__((ext_vector_type(2)));

constexpr int DM = 2048, M_CTX = 8192, M_LAT = 32768, MT = 40960;
constexpr float SCALE = 0.088388347648318440f;
constexpr float LOG2E = 1.4426950408889634f;
constexpr float LINIT = 0.35550906759f;
constexpr int NTHREADS = 512;
constexpr int XB_ST_OFF = 149504;
constexpr int LDS_BYTES = 149504 + 16;

constexpr size_t O_YP = 0, O_YS = 16777216, O_AK = 83886080, O_AV = 92274688, O_BK = 100663296, O_BV = 117440512, O_CK = 134217728, O_CV = 150994944;

constexpr size_t WS_WTA = 0;
constexpr size_t WS_WTB = WS_WTA + 41943040;
constexpr size_t WS_WTC = WS_WTB + 33554432;
constexpr size_t WS_WTO = WS_WTC + 33554432;
constexpr size_t WS_CACHE = WS_WTO + 33554432;
constexpr size_t WS_PART = WS_CACHE + 41943040;
constexpr size_t WS_MODA = WS_PART + 14155776;
constexpr size_t WS_MODB = WS_MODA + 294912;
constexpr size_t WS_GATE = WS_MODB + 294912;
constexpr size_t WS_ROPE = WS_GATE + 294912;
constexpr size_t WS_MISC = WS_ROPE + 16384;
constexpr size_t WS_H = WS_MISC + 4096;
constexpr size_t WS_QKVG = WS_H + 167772160;
constexpr size_t WS_BAR = WS_QKVG + 671088640;
constexpr size_t WS_END = WS_QKVG + 671088640 + 65536;
constexpr size_t C_AK = 0, C_AV = 2097152, C_BK = 4194304, C_BV = 8388608, C_CK = 12582912, C_CV = 16777216;

struct Params { const float* in[23]; float* out; unsigned char* ws; };

DI unsigned cvtpk(float lo, float hi) { unsigned r; asm volatile("v_cvt_pk_bf16_f32 %0, %1, %2" : "=v"(r) : "v"(lo), "v"(hi)); return r; }
DI float bf_lo(unsigned w) { return __uint_as_float(w << 16); }
DI float bf_hi(unsigned w) { return __uint_as_float(w & 0xffff0000u); }
DI float bf2f(bf16_t x) { return __uint_as_float((unsigned)x << 16); }
DI float silu_f(float g) { return g / (1.f + __expf(-g)); }
DI float shx(float v, int m, int lane) { return __int_as_float(__builtin_amdgcn_ds_bpermute((lane ^ m) << 2, __float_as_int(v))); }

DI int hd_phys(int e) { const int a = e >> 6, half = (e >> 5) & 1, f = e & 31, pi = 32 * a + f; return 8 * (pi >> 2) + 2 * (pi & 3) + half; }

namespace pg8 {
constexpr int BM = 256, BK = 64, HALF = 128, HTB = HALF * BK * 2, STAGE_BYTES = 8 * HTB, NXCD = 8, WGM = 8;
DI int lds_byte(int r, int c) { const int st = (r >> 4) * 2 + (c >> 5), rr = r & 15, cc = c & 31, ob = rr * 64 + cc * 2; return st * 1024 + (ob ^ (((ob >> 9) & 1) << 5)); }
DI void stage_rc(int b, int& R, int& C) { const int st = b / 1024, sb = b % 1024, swz = sb ^ (((sb >> 9) & 1) << 5); R = (st >> 1) * 16 + swz / 64; C = (st & 1) * 32 + (swz % 64) / 2; }
DI int perm32(int rho) { const int n = rho >> 4, i = rho & 15; return 8 * (i >> 2) + 4 * n + (i & 3); }
struct Unit { int pm, pn; };
struct Gemm { const bf16_t* A; const bf16_t* Bt; int M, N, K; };
struct StaticOrder {
    int nM, nN, nwg, G, c;
    DI void init(int M, int N, int G_, int c_) { nM = M / BM; nN = N / BM; nwg = nM * nN; G = G_; c = c_; }
    DI bool next(int i, Unit& u) const {
        const long L = (long)i * G + c; if (L >= nwg) return false;
        int wgid = (int)L; { const int q = nwg / NXCD, r = nwg % NXCD, xcd = wgid % NXCD, off = wgid / NXCD; wgid = (xcd < r ? xcd * (q + 1) : r * (q + 1) + (xcd - r) * q) + off; }
        const int nig = WGM * nN, gid = wgid / nig, fm = gid * WGM, gsz = (nM - fm) < WGM ? (nM - fm) : WGM;
        u.pm = fm + ((wgid % nig) % gsz); u.pn = (wgid % nig) / gsz; return true;
    }
};

struct EpiQKVG {
    static constexpr bool PERM = true;
    bf16_t* O; int ldc; int nqk, nv0, nv1; const float* qg; const float* kg; const float* cosT; int do_rope; float* kout; float* vout; int kindA, jdx;
    DI void operator()(const f32x4 (&acc)[2][2][4][2], const Unit& u, int wr, int wc, int fr, int fq, LAS unsigned char* lds) const {
        { int ln_; asm volatile("v_mbcnt_lo_u32_b32 %0, -1, 0\n\tv_mbcnt_hi_u32_b32 %0, -1, %0" : "=v"(ln_)); fr = ln_ & 15; fq = ln_ >> 4; }
        const int row0 = u.pm * BM + wr * 64 + fr; const int col0 = u.pn * BM + wc * 32 + 8 * fq;
        const bool ctx = u.pm < 32;
        if (u.pn >= nqk) {
            const bool vt = ctx && u.pn >= nv0 && u.pn < nv1;
#pragma unroll
            for (int ai = 0; ai < 2; ++ai)
#pragma unroll
                for (int m = 0; m < 4; ++m) { const int row = row0 + ai * HALF + m * 16; bf16_t* rowp = O + (size_t)row * ldc + col0;
#pragma unroll
                    for (int bj = 0; bj < 2; ++bj) { const f32x4 v0 = acc[ai][bj][m][0], v1 = acc[ai][bj][m][1];
                        u32x4 w; w.x = cvtpk(v0[0], v0[1]); w.y = cvtpk(v0[2], v0[3]); w.z = cvtpk(v1[0], v1[1]); w.w = cvtpk(v1[2], v1[3]);
                        *(u32x4*)(rowp + bj * HALF) = w;
                        if (vt) { const int vc = col0 + bj * HALF - nv0 * BM;
                            float* d = kindA ? vout + ((size_t)((u.pm * 2 + jdx) * 256 + (row & 255))) * 512 + vc : vout + (size_t)row * 2048 + vc;
                            *(f32x4*)d = v0; *(f32x4*)(d + 4) = v1; } } }
            return;
        }
        const int L = wc * 4 + fq, ax = L >> 3, f0 = (L & 7) * 4;
        const float* gs = (u.pn < 8) ? qg : kg;
        const f32x4 g0 = *(const f32x4*)(gs + 64 * ax + f0), g1 = *(const f32x4*)(gs + 64 * ax + 32 + f0);
        LAS float* part = (LAS float*)(lds + 131072);
#pragma unroll
        for (int ai = 0; ai < 2; ++ai)
#pragma unroll
            for (int m = 0; m < 4; ++m)
#pragma unroll
                for (int bj = 0; bj < 2; ++bj) { const f32x4 x0 = acc[ai][bj][m][0], x1 = acc[ai][bj][m][1];
                    float ss = x0[0] * x0[0] + x0[1] * x0[1] + x0[2] * x0[2] + x0[3] * x0[3] + x1[0] * x1[0] + x1[1] * x1[1] + x1[2] * x1[2] + x1[3] * x1[3];
                    { auto r16 = __builtin_amdgcn_permlane16_swap(__float_as_uint(ss), __float_as_uint(ss), false, false); ss = __uint_as_float(r16[0]) + __uint_as_float(r16[1]);
                      auto r32_ = __builtin_amdgcn_permlane32_swap(__float_as_uint(ss), __float_as_uint(ss), false, false); ss = __uint_as_float(r32_[0]) + __uint_as_float(r32_[1]); }
                    if (fq == 0) part[(((((wr * 2 + ai) * 4 + m) * 16 + fr) * 2 + bj) << 2) + wc] = ss; }
        asm volatile("s_waitcnt lgkmcnt(0)" ::: "memory"); __builtin_amdgcn_s_barrier(); asm volatile("" ::: "memory");
        const bool rope = (!ctx) && do_rope; const bool kt = ctx && u.pn >= 8;
        f32x4 cs[2][4], sn[2][4];
#pragma unroll
        for (int ai = 0; ai < 2; ++ai)
#pragma unroll
            for (int m = 0; m < 4; ++m) { cs[ai][m] = (f32x4){1.f, 1.f, 1.f, 1.f}; sn[ai][m] = (f32x4){0.f, 0.f, 0.f, 0.f};
                if (rope) { const int row = row0 + ai * HALF + m * 16; const int n = (row - M_CTX) & 4095; const int pos = ax ? (n & 63) : (n >> 6);
                    cs[ai][m] = *(const f32x4*)(cosT + pos * 32 + f0); sn[ai][m] = *(const f32x4*)(cosT + 2048 + pos * 32 + f0); } }
#pragma unroll
        for (int ai = 0; ai < 2; ++ai)
#pragma unroll
            for (int m = 0; m < 4; ++m) { const int row = row0 + ai * HALF + m * 16; bf16_t* rowp = O + (size_t)row * ldc + col0;
                const f32x4 c4 = cs[ai][m], s4 = sn[ai][m];
#pragma unroll
                for (int bj = 0; bj < 2; ++bj) { const f32x4 x0 = acc[ai][bj][m][0], x1 = acc[ai][bj][m][1];
                    const f32x4 pt = *(const LAS f32x4*)(part + (((((wr * 2 + ai) * 4 + m) * 16 + fr) * 2 + bj) << 2));
                    const float rs = rsqrtf((pt[0] + pt[1] + pt[2] + pt[3]) * (1.f / 128.f) + 1e-6f);
                    f32x4 h0 = {x0[0] * rs * g0[0], x0[2] * rs * g0[1], x1[0] * rs * g0[2], x1[2] * rs * g0[3]};
                    f32x4 h1 = {x0[1] * rs * g1[0], x0[3] * rs * g1[1], x1[1] * rs * g1[2], x1[3] * rs * g1[3]};
                    const f32x4 r0 = h0 * c4 - h1 * s4, r1 = h1 * c4 + h0 * s4;
                    u32x4 w; w.x = cvtpk(r0[0], r1[0]); w.y = cvtpk(r0[1], r1[1]); w.z = cvtpk(r0[2], r1[2]); w.w = cvtpk(r0[3], r1[3]);
                    *(u32x4*)(rowp + bj * HALF) = w;
                    if (kt) { const int hk = (u.pn - 8) * 2 + bj;
                        float* d = (kindA ? kout + ((size_t)((u.pm * 2 + jdx) * 256 + (row & 255))) * 512 : kout + (size_t)row * 2048) + hk * 128 + 64 * ax + f0;
                        *(f32x4*)d = r0; *(f32x4*)(d + 32) = r1; } } }
    }
};
struct EpiOut {
    static constexpr bool PERM = false;
    const float* xin_ctx; const float* xin_lat; float* out; const float* gate;
    DI void operator()(const f32x4 (&acc)[2][2][4][2], const Unit& u, int wr, int wc, int fr, int fq, LAS unsigned char*) const {
        const int row0 = u.pm * BM + wr * 64 + fr, col0 = u.pn * BM + wc * 32 + 4 * fq;
        const bool ctx = u.pm < 32; const int r9 = ctx ? 0 : 1 + ((u.pm - 32) >> 4);
        const float* xb = ctx ? xin_ctx : xin_lat; const int rsub = ctx ? 0 : M_CTX;
        f32x4 gv[2][2];
#pragma unroll
        for (int bj = 0; bj < 2; ++bj)
#pragma unroll
            for (int n = 0; n < 2; ++n) gv[bj][n] = *(const f32x4*)(gate + r9 * DM + col0 + bj * HALF + n * 16);
        f32x4 xr_[3][2][2];
#define EPO_LD(g, slot) do { const int _row = row0 + ((g) >> 2) * HALF + ((g) & 3) * 16; const float* _xr = xb + (size_t)(_row - rsub) * DM + col0;      \
        _Pragma("unroll") for (int bj = 0; bj < 2; ++bj) _Pragma("unroll") for (int n = 0; n < 2; ++n) xr_[slot][bj][n] = *(const f32x4*)(_xr + bj * HALF + n * 16); } while (0)
        EPO_LD(0, 0); EPO_LD(1, 1); EPO_LD(2, 2);
#pragma unroll
        for (int g = 0; g < 8; ++g) { const int ai = g >> 2, m = g & 3, slot = g % 3; const int row = row0 + ai * HALF + m * 16; float* orow = out + (size_t)row * DM + col0;
#pragma unroll
            for (int bj = 0; bj < 2; ++bj)
#pragma unroll
                for (int n = 0; n < 2; ++n) *(f32x4*)(orow + bj * HALF + n * 16) = xr_[slot][bj][n] + gv[bj][n] * acc[ai][bj][m][n];
            __builtin_amdgcn_sched_barrier(0);
            if (g + 3 < 8) { if (slot == 0) EPO_LD(g + 3, 0); else if (slot == 1) EPO_LD(g + 3, 1); else EPO_LD(g + 3, 2); }
            __builtin_amdgcn_sched_barrier(0); }
#undef EPO_LD
    }
};

template <class Epi, class Sched>
DI void gemm_phase(LAS unsigned char* lds, const Gemm g, const Sched& S, const Epi& E) {
    int tid_ = threadIdx.x; asm volatile("" : "+v"(tid_));
    const int tid = tid_, wid = __builtin_amdgcn_readfirstlane(tid >> 6), lane = tid & 63, wr = wid >> 2, wc = wid & 3, fr = lane & 15, fq = lane >> 4;
    const int K = g.K, nt = K / BK;
    unsigned voffA[2], voffB[2];
#pragma unroll
    for (int i = 0; i < 2; ++i) { int R, C; stage_rc(tid * 16 + i * 8192, R, C); const int Rb = Epi::PERM ? ((R & ~31) + perm32(R & 31)) : R;
        voffA[i] = (unsigned)(R * K + C) * 2u; voffB[i] = (unsigned)(Rb * K + C) * 2u; }
    const size_t kstep = (size_t)(BK * 2);
    const size_t hstep = (size_t)HALF * K * 2;
    const size_t tstep = 2 * hstep;
    const unsigned ldsw = (unsigned)wid * 1024u;
    const int aoff = lds_byte(wr * 64 + fr, fq * 8), boff = lds_byte(wc * 32 + fr, fq * 8);
#define PG8_SA(b, h) (((b) * 2 + (h)) * HTB)
#define PG8_SB(b, h) ((4 + (b) * 2 + (h)) * HTB)
#define PG8_STAGE(bufoff, gbase, voff) do { _Pragma("unroll") for (int _i = 0; _i < 2; ++_i) \
        __builtin_amdgcn_global_load_lds((const unsigned*)((const char*)(gbase) + (voff)[_i]), (LAS unsigned*)(lds + (bufoff) + ldsw + _i * 8192), 16, 0, 0); } while (0)
#define PG8_LDA(dst, b, h) do { _Pragma("unroll") for (int m = 0; m < 4; ++m) _Pragma("unroll") for (int k = 0; k < 2; ++k) dst[m][k] = *(const LAS bf16x8*)(lds + PG8_SA(b, h) + aoff + m * 2048 + k * 1024); } while (0)
#define PG8_LDB(dst, b, h) do { _Pragma("unroll") for (int n = 0; n < 2; ++n) _Pragma("unroll") for (int k = 0; k < 2; ++k) dst[n][k] = *(const LAS bf16x8*)(lds + PG8_SB(b, h) + boff + n * 2048 + k * 1024); } while (0)
#define PG8_MMA(ai, bj, At, Bt) do { __builtin_amdgcn_s_setprio(1); _Pragma("unroll") for (int m = 0; m < 4; ++m) _Pragma("unroll") for (int n = 0; n < 2; ++n) _Pragma("unroll") for (int k = 0; k < 2; ++k) \
        acc[ai][bj][m][n] = __builtin_amdgcn_mfma_f32_16x16x32_bf16(Bt[n][k], At[m][k], acc[ai][bj][m][n], 0, 0, 0); __builtin_amdgcn_s_setprio(0); } while (0)
#define PG8_WAIT_V(n) asm volatile("s_waitcnt vmcnt(" #n ")" ::: "memory")
#define PG8_WAIT_L(n) asm volatile("s_waitcnt lgkmcnt(" #n ")" ::: "memory")
#define PG8_BAR __builtin_amdgcn_s_barrier()
#define PG8_SCHED __builtin_amdgcn_sched_barrier(0)
    Unit cur, nxt; int ui = 0;
    if (!S.next(0, cur)) return;
    f32x4 acc[2][2][4][2];
#pragma unroll
    for (int a = 0; a < 2; ++a)
#pragma unroll
        for (int b = 0; b < 2; ++b)
#pragma unroll
            for (int m = 0; m < 4; ++m)
#pragma unroll
                for (int n = 0; n < 2; ++n) acc[a][b][m][n] = (f32x4){0.f, 0.f, 0.f, 0.f};
    bf16x8 At[4][2], B0[2][2], B1[2][2];
    const char* cA = (const char*)g.A + (size_t)cur.pm * tstep; const char* cB = (const char*)g.Bt + (size_t)cur.pn * tstep;
    PG8_STAGE(PG8_SB(0, 0), cB, voffB); PG8_STAGE(PG8_SA(0, 0), cA, voffA); PG8_STAGE(PG8_SB(0, 1), cB + hstep, voffB); PG8_STAGE(PG8_SA(0, 1), cA + hstep, voffA);
    if (wr == 1) PG8_BAR;
    PG8_WAIT_V(4); PG8_BAR;
    PG8_STAGE(PG8_SB(1, 0), cB + kstep, voffB); PG8_STAGE(PG8_SA(1, 0), cA + kstep, voffA); PG8_STAGE(PG8_SB(1, 1), cB + hstep + kstep, voffB);
    PG8_WAIT_V(6); PG8_BAR;
    for (;;) {
        const bool has_next = S.next(ui + 1, nxt);
        const char* nA = has_next ? (const char*)g.A + (size_t)nxt.pm * tstep : cA; const char* nB = has_next ? (const char*)g.Bt + (size_t)nxt.pn * tstep : cB;
        for (int t = 0; t < nt; t += 2) {
            const bool last = (t == nt - 2);
            const char* a1 = cA + (size_t)(t + 1) * kstep;
            const char* a2 = last ? nA : cA + (size_t)(t + 2) * kstep; const char* b2 = last ? nB : cB + (size_t)(t + 2) * kstep;
            const char* a3 = a2 + kstep; const char* b3 = b2 + kstep;
            PG8_LDB(B0, 0, 0); PG8_SCHED; PG8_LDA(At, 0, 0); PG8_STAGE(PG8_SA(1, 1), a1 + hstep, voffA);
            PG8_WAIT_L(8); PG8_BAR; PG8_WAIT_L(0); PG8_MMA(0, 0, At, B0); PG8_BAR; PG8_SCHED;
            PG8_LDB(B1, 0, 1); PG8_STAGE(PG8_SB(0, 0), b2, voffB);
            PG8_BAR; PG8_WAIT_L(0); PG8_MMA(0, 1, At, B1); PG8_BAR;
            PG8_LDA(At, 0, 1); PG8_STAGE(PG8_SA(0, 0), a2, voffA);
            PG8_BAR; PG8_WAIT_L(0); PG8_MMA(1, 0, At, B0); PG8_BAR; PG8_SCHED;
            PG8_STAGE(PG8_SB(0, 1), b2 + hstep, voffB);
            PG8_WAIT_V(6); PG8_BAR; PG8_MMA(1, 1, At, B1); PG8_BAR;
            PG8_LDB(B0, 1, 0); PG8_SCHED; PG8_LDA(At, 1, 0); PG8_STAGE(PG8_SA(0, 1), a2 + hstep, voffA);
            PG8_WAIT_L(8); PG8_BAR; PG8_WAIT_L(0); PG8_MMA(0, 0, At, B0); PG8_BAR; PG8_SCHED;
            PG8_LDB(B1, 1, 1); PG8_STAGE(PG8_SB(1, 0), b3, voffB);
            PG8_BAR; PG8_WAIT_L(0); PG8_MMA(0, 1, At, B1); PG8_BAR;
            PG8_LDA(At, 1, 1); PG8_STAGE(PG8_SA(1, 0), a3, voffA);
            PG8_BAR; PG8_WAIT_L(0); PG8_MMA(1, 0, At, B0); PG8_BAR; PG8_SCHED;
            PG8_STAGE(PG8_SB(1, 1), b3 + hstep, voffB);
            PG8_WAIT_V(6); PG8_BAR; PG8_MMA(1, 1, At, B1); PG8_BAR;
        }
        E(acc, cur, wr, wc, fr, fq, lds);
        if (!has_next) break;
#pragma unroll
        for (int a = 0; a < 2; ++a)
#pragma unroll
            for (int b = 0; b < 2; ++b)
#pragma unroll
                for (int m = 0; m < 4; ++m)
#pragma unroll
                    for (int n = 0; n < 2; ++n) acc[a][b][m][n] = (f32x4){0.f, 0.f, 0.f, 0.f};
        cur = nxt; cA = nA; cB = nB; ++ui;
    }
    PG8_WAIT_V(0);
    if (wr == 0) PG8_BAR;
    PG8_BAR;
#undef PG8_SA
#undef PG8_SB
#undef PG8_STAGE
#undef PG8_LDA
#undef PG8_LDB
#undef PG8_MMA
#undef PG8_WAIT_V
#undef PG8_WAIT_L
#undef PG8_BAR
#undef PG8_SCHED
}
}

constexpr float THR = 8.f;
constexpr int STG = 16384;
constexpr int KST_OFF = 0, VST_OFF = 65536, WSL_OFF = 131072, RPB_OFF = 133120;
#define KSWZ(row, colB) ((row) * 256 + ((colB) ^ (((row) & 7) << 4)))
#define SBAR() __builtin_amdgcn_sched_barrier(0)
DI int crow(int r, int hi) { return (r & 3) + 8 * (r >> 2) + 4 * hi; }

struct AttnArgs {
    const bf16_t* Q; long ldq;
    const bf16_t* K0; const bf16_t* V0; long ld0; int n0;
    const bf16_t* K1; const bf16_t* V1; long ld1; int n1; int s1_start, s1_max;
    int mode;
    int qpos0, r0, rbase;
    int has_sink; float sinkl2;
    int out_mode;
    bf16_t* O; long ldo; const bf16_t* Gp; long ldg;
    int fuse; const float* subln; float lam;
};

DI void apply_mask(f32x16& p0, f32x16& p1, const AttnArgs& a, int j, int wid, int r32, int hi, const LAS float* rpbL) {
    if (a.mode == 0 || j < a.n0) return;
    { int l2 = r32 | (hi << 5); asm volatile("" : "+v"(l2)); r32 = l2 & 31; hi = l2 >> 5; }
    const int jl = j - a.n0;
#ifndef ATT_NOMODE1
    if (a.mode == 1) {
        const int kbase = a.s1_start + jl * 64;
        const bool tv = (kbase >= 0) && (kbase < 4096);
        { const int qlo = a.qpos0 + wid * 32; if (tv && kbase >= qlo + 31 - 128 && kbase + 63 <= qlo + 128) return; }
        int dqh = tv ? (kbase - (a.qpos0 + wid * 32 + r32) + 4 * hi + 128) : 1000000;
        asm volatile("" : "+v"(dqh));
#pragma unroll
        for (int r = 0; r < 16; ++r) { const int cq = (r & 3) + 8 * (r >> 2);
            p0[r] = ((unsigned)(dqh + cq) <= 256u) ? p0[r] : -1e30f;
            p1[r] = ((unsigned)(dqh + cq + 32) <= 256u) ? p1[r] : -1e30f; }
    }
#else
    if (0) {}
#endif
#ifndef ATT_NOMODE2
    else {
        const int kr = a.rbase + jl, r = a.r0 + (wid >> 1); const int rs = min(max(r - 4, 0), 56);
        const bool tv = (kr >= rs) && (kr < rs + 8);
        if (!tv) {
#pragma unroll
            for (int q = 0; q < 16; ++q) { p0[q] = -1e30f; p1[q] = -1e30f; }
        } else {
            const int c = (wid & 1) * 32 + r32; const int cs = min(max(c - 8, 0), 48);
            int tq = 4 * hi - cs;
            int bidx = (kr - r + 7) * 31 + 15 - c + 4 * hi;
            asm volatile("" : "+v"(tq), "+v"(bidx));
            const LAS float* bp = rpbL + bidx;
#pragma unroll
            for (int q = 0; q < 16; ++q) { const int cq = (q & 3) + 8 * (q >> 2);
                const float b0 = bp[cq], b1 = bp[cq + 32];
                p0[q] = ((unsigned)(tq + cq) < 16u) ? p0[q] + b0 : -1e30f; p1[q] = ((unsigned)(tq + cq + 32) < 16u) ? p1[q] + b1 : -1e30f;
                if ((q & 3) == 3) SBAR(); }
        }
    }
#endif
}
DI bool tile_dead(const AttnArgs& a, int j, int wid) {
    if (a.mode == 0 || j < a.n0) return false;
    const int jl = j - a.n0;
    if (a.mode == 1) { const int kbase = a.s1_start + jl * 64, qlo = a.qpos0 + wid * 32;
        return !((kbase >= 0) && (kbase < 4096) && (kbase + 63 >= qlo - 128) && (kbase <= qlo + 31 + 128)); }
    const int kr = a.rbase + jl, r = a.r0 + (wid >> 1); const int rs = min(max(r - 4, 0), 56);
    return !((kr >= rs) && (kr < rs + 8));
}
DI void partialSM(f32x16& p0, f32x16& p1, float& m_reg, float& mn, float& alpha) {
    constexpr float C = SCALE * LOG2E;
    float pmax = p0[0];
#pragma unroll
    for (int r = 1; r < 16; ++r) pmax = fmaxf(pmax, p0[r]);
#pragma unroll
    for (int r = 0; r < 16; ++r) pmax = fmaxf(pmax, p1[r]);
    { auto rr = __builtin_amdgcn_permlane32_swap(__float_as_uint(pmax), __float_as_uint(pmax), false, false);
      pmax = fmaxf(__uint_as_float(rr[0]), __uint_as_float(rr[1])); }
    if (__builtin_expect(__all(pmax - m_reg <= THR / SCALE), 1)) { mn = m_reg; alpha = 1.f; }
    else { mn = fmaxf(m_reg, pmax); alpha = __builtin_amdgcn_exp2f((m_reg - mn) * C); m_reg = mn; }
    const float mnC = -mn * C;
#pragma unroll
    for (int r = 0; r < 16; ++r) p0[r] = fmaf(p0[r], C, mnC);
#pragma unroll
    for (int r = 0; r < 16; ++r) p1[r] = fmaf(p1[r], C, mnC);
#pragma unroll
    for (int r = 0; r < 16; ++r) p0[r] = __builtin_amdgcn_exp2f(p0[r]);
}
DI void finishSM(f32x16& p0, f32x16& p1, float alpha, float& l_reg, bf16x8& pa0, bf16x8& pa1, bf16x8& pa2, bf16x8& pa3) {
#pragma unroll
    for (int r = 0; r < 16; ++r) p1[r] = __builtin_amdgcn_exp2f(p1[r]);
    float ps = 0;
#pragma unroll
    for (int r = 0; r < 16; ++r) ps += p0[r];
#pragma unroll
    for (int r = 0; r < 16; ++r) ps += p1[r];
    { auto rr = __builtin_amdgcn_permlane32_swap(__float_as_uint(ps), __float_as_uint(ps), false, false);
      ps = __uint_as_float(rr[0]) + __uint_as_float(rr[1]); }
    l_reg = l_reg * alpha + ps;
#define PK4(P, BASE, OUT) do { unsigned a0 = cvtpk(P[BASE + 0], P[BASE + 1]), a1 = cvtpk(P[BASE + 2], P[BASE + 3]);   \
    unsigned b0 = cvtpk(P[BASE + 4], P[BASE + 5]), b1 = cvtpk(P[BASE + 6], P[BASE + 7]);                              \
    auto r0 = __builtin_amdgcn_permlane32_swap(a0, b0, false, false); auto r1 = __builtin_amdgcn_permlane32_swap(a1, b1, false, false); \
    u32x4 w = {r0[0], r1[0], r0[1], r1[1]}; OUT = *reinterpret_cast<bf16x8*>(&w); } while (0)
    PK4(p0, 0, pa0); PK4(p0, 8, pa1); PK4(p1, 0, pa2); PK4(p1, 8, pa3);
#undef PK4
}
DI void qkt(f32x16& p0, f32x16& p1, const LAS unsigned char* Ks, const bf16x8* qr, int r32, int hi) {
    p0 = f32x16{}; p1 = f32x16{};
    { int l2 = r32 | (hi << 5); asm volatile("" : "+v"(l2)); r32 = l2 & 31; hi = l2 >> 5; }
#pragma unroll
    for (int d0 = 0; d0 < 8; ++d0) { const int cb = (d0 * 16 + hi * 8) * 2;
        bf16x8 b0 = *reinterpret_cast<const LAS bf16x8*>(Ks + KSWZ(r32, cb));
        bf16x8 b1 = *reinterpret_cast<const LAS bf16x8*>(Ks + KSWZ(32 + r32, cb));
        p0 = __builtin_amdgcn_mfma_f32_32x32x16_bf16(b0, qr[d0], p0, 0, 0, 0);
        p1 = __builtin_amdgcn_mfma_f32_32x32x16_bf16(b1, qr[d0], p1, 0, 0, 0);
        if (d0 == 3) SBAR(); }
}
DI int v_st(int k, int c) { const int kk = (k & ~0xC) | ((k & 4) << 1) | ((k & 8) >> 1); return ((kk >> 3) * 4 + (c >> 5)) * 512 + ((kk & 7) * 32 + (c & 31)) * 2; }
DI int v_rd_base(int lane) { return ((lane & 3) << 3) | (((lane >> 2) & 3) << 6) | (((lane >> 4) & 1) << 5) | (((lane >> 5) & 1) << 8); }
constexpr int v_rd_off(int d0, int ks, int half) { return d0 * 512 + ks * 4096 + half * 2048; }
template <int OFF> DI s16x4 tr_read(int vb) {
    s16x4 r; asm volatile("ds_read_b64_tr_b16 %0, %1 offset:%2" : "=&v"(r) : "v"(vb), "i"(OFF) : "memory"); return r;
}
template <int D0> DI void pv_one(f32x16& od, int vb, bf16x8 pa0, bf16x8 pa1, bf16x8 pa2, bf16x8 pa3) {
    const s16x4 l0 = tr_read<v_rd_off(D0, 0, 0)>(vb), h0 = tr_read<v_rd_off(D0, 0, 1)>(vb), l1 = tr_read<v_rd_off(D0, 1, 0)>(vb), h1 = tr_read<v_rd_off(D0, 1, 1)>(vb);
    const s16x4 l2 = tr_read<v_rd_off(D0, 2, 0)>(vb), h2 = tr_read<v_rd_off(D0, 2, 1)>(vb), l3 = tr_read<v_rd_off(D0, 3, 0)>(vb), h3 = tr_read<v_rd_off(D0, 3, 1)>(vb);
    asm volatile("s_waitcnt lgkmcnt(0)" ::: "memory"); SBAR();
#define PK(L, H) (bf16x8){L[0], L[1], L[2], L[3], H[0], H[1], H[2], H[3]}
    od = __builtin_amdgcn_mfma_f32_32x32x16_bf16(pa0, PK(l0, h0), od, 0, 0, 0);
    od = __builtin_amdgcn_mfma_f32_32x32x16_bf16(pa1, PK(l1, h1), od, 0, 0, 0);
    od = __builtin_amdgcn_mfma_f32_32x32x16_bf16(pa2, PK(l2, h2), od, 0, 0, 0);
    od = __builtin_amdgcn_mfma_f32_32x32x16_bf16(pa3, PK(l3, h3), od, 0, 0, 0);
#undef PK
}
#define PV_RD(S, D0, VB) const s16x4 S##l0 = tr_read<v_rd_off(D0, 0, 0)>(VB), S##h0 = tr_read<v_rd_off(D0, 0, 1)>(VB), S##l1 = tr_read<v_rd_off(D0, 1, 0)>(VB), S##h1 = tr_read<v_rd_off(D0, 1, 1)>(VB), \
                               S##l2 = tr_read<v_rd_off(D0, 2, 0)>(VB), S##h2 = tr_read<v_rd_off(D0, 2, 1)>(VB), S##l3 = tr_read<v_rd_off(D0, 3, 0)>(VB), S##h3 = tr_read<v_rd_off(D0, 3, 1)>(VB)
#define PV_PK(L, H) (bf16x8){L[0], L[1], L[2], L[3], H[0], H[1], H[2], H[3]}
#define PV_MM(S, OD) do { OD = __builtin_amdgcn_mfma_f32_32x32x16_bf16(pa0, PV_PK(S##l0, S##h0), OD, 0, 0, 0); OD = __builtin_amdgcn_mfma_f32_32x32x16_bf16(pa1, PV_PK(S##l1, S##h1), OD, 0, 0, 0); \
                          OD = __builtin_amdgcn_mfma_f32_32x32x16_bf16(pa2, PV_PK(S##l2, S##h2), OD, 0, 0, 0); OD = __builtin_amdgcn_mfma_f32_32x32x16_bf16(pa3, PV_PK(S##l3, S##h3), OD, 0, 0, 0); } while (0)
#define PV_W8() do { asm volatile("s_waitcnt lgkmcnt(8)" ::: "memory"); SBAR(); } while (0)
#define PV_W0() do { asm volatile("s_waitcnt lgkmcnt(0)" ::: "memory"); SBAR(); } while (0)
template <int NH> DI void pv_pipe(f32x16* o, int vb, bf16x8 pa0, bf16x8 pa1, bf16x8 pa2, bf16x8 pa3) {
    SBAR();
    { PV_RD(a, 0, vb); SBAR();
      { PV_RD(b, 1, vb); PV_W8(); PV_MM(a, o[0]); SBAR();
        { PV_RD(c, 2, vb); PV_W8(); PV_MM(b, o[1]); SBAR();
          { PV_RD(d, 3, vb); PV_W8(); PV_MM(c, o[2]); SBAR();
            if constexpr (NH == 1) { PV_W0(); PV_MM(d, o[3]); SBAR(); }
            else { const int vb2 = vb + STG;
              { PV_RD(e, 0, vb2); PV_W8(); PV_MM(d, o[3]); SBAR();
                { PV_RD(f, 1, vb2); PV_W8(); PV_MM(e, o[4]); SBAR();
                  { PV_RD(g, 2, vb2); PV_W8(); PV_MM(f, o[5]); SBAR();
                    { PV_RD(h, 3, vb2); PV_W8(); PV_MM(g, o[6]); SBAR();
                      PV_W0(); PV_MM(h, o[7]); SBAR(); } } } } } } } } }
}
DI void pv_d0(f32x16* o, int vb, bf16x8 pa0, bf16x8 pa1, bf16x8 pa2, bf16x8 pa3) { pv_pipe<1>(o, vb, pa0, pa1, pa2, pa3); }

DI void attn_body(const AttnArgs& a, LAS unsigned char* lds) {
    int tid_ = threadIdx.x; asm volatile("" : "+v"(tid_));
    const int tid = tid_, wid = __builtin_amdgcn_readfirstlane(tid >> 6), lane = tid & 63, r32 = lane & 31, hi = lane >> 5;
    LAS unsigned char* Kst = lds + KST_OFF; LAS unsigned char* Vst = lds + VST_OFF;
    LAS float* wsl = (LAS float*)(lds + WSL_OFF) + wid * 64; LAS float* li_l = wsl; LAS float* al_l = wsl + 32;
    const LAS float* rpbL = (const LAS float*)(lds + RPB_OFF);
    float m_reg = -1e30f, l_reg = 0; f32x16 o[4] = {}; bf16x8 qr[8];
    const bf16_t* Qw = a.Q + (long)(wid * 32 + r32) * a.ldq + hi * 8;
#pragma unroll
    for (int d0 = 0; d0 < 8; ++d0) qr[d0] = *reinterpret_cast<const bf16x8*>(Qw + d0 * 16);
    const int vb0 = (int)(size_t)Vst + v_rd_base(lane);
#define ISSUE(jt, ST) do { const int _j = (jt); const char* _k; const char* _v; unsigned _ld;                                   \
    if (_j < a.n0) { _ld = (unsigned)a.ld0 * 2u; const size_t _o = (size_t)_j * 64 * _ld; _k = (const char*)a.K0 + _o; _v = (const char*)a.V0 + _o; }                         \
    else { int _st = a.s1_start + (_j - a.n0) * 64; _st = max(0, min(_st, a.s1_max)); _ld = (unsigned)a.ld1 * 2u; const size_t _o = (size_t)_st * _ld; _k = (const char*)a.K1 + _o; _v = (const char*)a.V1 + _o; } \
    unsigned _ln = (unsigned)lane; asm volatile("" : "+v"(_ln));                                                                  \
    _Pragma("unroll") for (int _i = 0; _i < 2; ++_i) { const unsigned _s = (unsigned)((wid * 2 + _i) * 64) + _ln;                 \
        const unsigned _rk = _s >> 4, _ck = ((_s & 15u) << 4) ^ ((_rk & 7u) << 4);                                                \
        const unsigned _sub = _s >> 5, _w5 = _s & 31u, _kk = (_sub >> 2) * 8u + (_w5 >> 2);                                         \
        const unsigned _rv = (_kk & ~0xCu) | ((_kk & 4u) << 1) | ((_kk & 8u) >> 1), _cv = ((_sub & 3u) * 32u + (_w5 & 3u) * 8u) * 2u; \
        unsigned _ok = _rk * _ld + _ck, _ov = _rv * _ld + _cv; asm volatile("" : "+v"(_ok), "+v"(_ov));                           \
        __builtin_amdgcn_global_load_lds((const unsigned*)(_k + _ok), (LAS unsigned*)(Kst + (ST) * STG + (wid * 2 + _i) * 1024), 16, 0, 0); \
        __builtin_amdgcn_global_load_lds((const unsigned*)(_v + _ov), (LAS unsigned*)(Vst + (ST) * STG + (wid * 2 + _i) * 1024), 16, 0, 0); } } while (0)
#define WAITV(n) asm volatile("s_waitcnt vmcnt(" #n ")" ::: "memory")
#define BAR() do { asm volatile("s_waitcnt lgkmcnt(0)" ::: "memory"); __builtin_amdgcn_s_barrier(); asm volatile("" ::: "memory"); SBAR(); } while (0)
#define RESC(al) do { if (__any((al) < 1.f)) { if (hi == 0) al_l[r32] = (al); asm volatile("s_waitcnt lgkmcnt(0)" ::: "memory"); \
    _Pragma("unroll") for (int d = 0; d < 4; ++d) _Pragma("unroll") for (int r = 0; r < 16; ++r) o[d][r] *= al_l[crow(r, hi)]; } } while (0)
    f32x16 pA0, pA1, pB0, pB1; float mnA, mnB, alA, alB; bf16x8 pa0, pa1, pa2, pa3; const int NT = a.n0 + a.n1;
#define STEP(X0, X1, mnX, alX, deadX, Y0, Y1, alY, deadY, jt, KS, VS) do { const int _jj = (jt);                                    \
    deadX = tile_dead(a, _jj, wid);                                                                                               \
    SBAR(); if (!deadX) qkt(X0, X1, Kst + (KS) * STG, qr, r32, hi);                                                               \
    else { _Pragma("unroll") for (int _q = 0; _q < 16; ++_q) { X0[_q] = -1e30f; X1[_q] = -1e30f; } }                              \
    SBAR();                                                                                                                       \
    if (!deadY) finishSM(Y0, Y1, alY, l_reg, pa0, pa1, pa2, pa3);                                                                 \
    SBAR();                                                                                                                       \
    if (_jj + 2 < NT) ISSUE(_jj + 2, ((KS) + 2) & 3);                                                                             \
    SBAR();                                                                                                                       \
    if (!deadY) pv_d0(o, vb0 + (VS) * STG, pa0, pa1, pa2, pa3);                                                                   \
    SBAR(); if (!deadX) { apply_mask(X0, X1, a, _jj, wid, r32, hi, rpbL); SBAR(); partialSM(X0, X1, m_reg, mnX, alX); RESC(alX); } \
    if (_jj + 2 < NT) WAITV(4); else WAITV(0);                                                                                    \
    BAR(); } while (0)
    bool deadA = false, deadB = false;
    ISSUE(0, 0); ISSUE(1, 1);
    WAITV(4); BAR();
    SBAR(); qkt(pA0, pA1, Kst, qr, r32, hi); SBAR();
    ISSUE(2, 2);
    SBAR(); apply_mask(pA0, pA1, a, 0, wid, r32, hi, rpbL); partialSM(pA0, pA1, m_reg, mnA, alA);
    WAITV(4); BAR();
#pragma unroll 1
    for (int j = 1; j < NT; j += 4) {
        STEP(pB0, pB1, mnB, alB, deadB, pA0, pA1, alA, deadA, j, 1, 0);
        STEP(pA0, pA1, mnA, alA, deadA, pB0, pB1, alB, deadB, j + 1, 2, 1);
        STEP(pB0, pB1, mnB, alB, deadB, pA0, pA1, alA, deadA, j + 2, 3, 2);
        if (j + 3 < NT) STEP(pA0, pA1, mnA, alA, deadA, pB0, pB1, alB, deadB, j + 3, 0, 3);
    }
    if (!deadB) { finishSM(pB0, pB1, alB, l_reg, pa0, pa1, pa2, pa3); SBAR();
        pv_d0(o, vb0 + 3 * STG, pa0, pa1, pa2, pa3); }
    if (a.has_sink) l_reg += __builtin_amdgcn_exp2f(a.sinkl2 - m_reg * (SCALE * LOG2E));
    if (hi == 0) li_l[r32] = l_reg; asm volatile("s_waitcnt lgkmcnt(0)" ::: "memory");
    float rli[16];
#pragma unroll
    for (int r = 0; r < 16; ++r) rli[r] = __builtin_amdgcn_rcpf(li_l[crow(r, hi)]);
    {
        int wu = wid; unsigned rl = (unsigned)r32 * 2u;
        asm volatile("" : "+s"(wu), "+v"(rl));
        char* Ow = (char*)(a.O + (size_t)(wu * 32) * a.ldo); const char* Gw = (const char*)(a.Gp + (size_t)(wu * 32) * a.ldg);
        const unsigned ldo2 = (unsigned)a.ldo * 2u, ldg2 = (unsigned)a.ldg * 2u;
        if (a.out_mode == 0) {
            BAR();
            unsigned ln = (unsigned)lane; asm volatile("" : "+v"(ln));
            u32x4 gw[8];
#pragma unroll
            for (int i = 0; i < 8; ++i) { const unsigned c = (unsigned)i * 64u + ln; gw[i] = *(const u32x4*)(Gw + (c >> 4) * ldg2 + (c & 15u) * 16u); }
            LAS float* img = (LAS float*)(lds + (unsigned)wu * 16384u);
            const unsigned wbase = (unsigned)hi * 4u * 128u + (ln & 31u);
#pragma unroll
            for (int r = 0; r < 16; ++r) { const unsigned ro = wbase + (unsigned)((r & 3) + 8 * (r >> 2)) * 128u;
                img[ro] = o[0][r] * rli[r]; img[ro + 32] = o[1][r] * rli[r]; img[ro + 64] = o[2][r] * rli[r]; img[ro + 96] = o[3][r] * rli[r]; }
            asm volatile("s_waitcnt lgkmcnt(0)" ::: "memory");
#pragma unroll
            for (int i = 0; i < 8; ++i) { const unsigned c = (unsigned)i * 64u + ln; const unsigned row = c >> 4, c8 = (c & 15u) * 8u;
                const f32x4 x0 = *(const LAS f32x4*)(img + row * 128u + c8), x1 = *(const LAS f32x4*)(img + row * 128u + c8 + 4);
                const u32x4 g = gw[i]; u32x4 w;
                w.x = cvtpk(x0[0] * silu_f(bf_lo(g.x)), x0[1] * silu_f(bf_hi(g.x))); w.y = cvtpk(x0[2] * silu_f(bf_lo(g.y)), x0[3] * silu_f(bf_hi(g.y)));
                w.z = cvtpk(x1[0] * silu_f(bf_lo(g.z)), x1[1] * silu_f(bf_hi(g.z))); w.w = cvtpk(x1[2] * silu_f(bf_lo(g.w)), x1[3] * silu_f(bf_hi(g.w)));
                *(u32x4*)(Ow + row * ldo2 + c8 * 2u) = w; }
        } else {
#pragma unroll
            for (int r = 0; r < 16; ++r) { const unsigned orow = (unsigned)crow(r, hi); const unsigned oo = orow * ldo2 + rl;
                const float v0 = o[0][r] * rli[r], v1 = o[1][r] * rli[r], v2 = o[2][r] * rli[r], v3 = o[3][r] * rli[r];
                *(bf16_t*)(Ow + oo) = (bf16_t)(cvtpk(v0, 0.f) & 0xffffu); *(bf16_t*)(Ow + oo + 64) = (bf16_t)(cvtpk(v1, 0.f) & 0xffffu);
                *(bf16_t*)(Ow + oo + 128) = (bf16_t)(cvtpk(v2, 0.f) & 0xffffu); *(bf16_t*)(Ow + oo + 192) = (bf16_t)(cvtpk(v3, 0.f) & 0xffffu); }
        }
    }
#undef ISSUE
#undef WAITV
#undef BAR
#undef RESC
#undef STEP
}

constexpr int BK_OFF = 0, BV_OFF = 49152, BWSL_OFF = 147456;
DI void attn_body_b(const AttnArgs& a, LAS unsigned char* lds) {
    int tid_ = threadIdx.x; asm volatile("" : "+v"(tid_));
    const int tid = tid_, wid = __builtin_amdgcn_readfirstlane(tid >> 6), lane = tid & 63, r32 = lane & 31, hi = lane >> 5;
    LAS unsigned char* Kst = lds + BK_OFF; LAS unsigned char* Vst = lds + BV_OFF;
    LAS float* wsl = (LAS float*)(lds + BWSL_OFF) + wid * 64; LAS float* li_l = wsl; LAS float* al_l = wsl + 32;
    float m_reg = -1e30f, l_reg = 0; f32x16 o[8] = {}; bf16x8 qr[8];
    const bf16_t* Qw = a.Q + (long)(wid * 32 + r32) * a.ldq + hi * 8;
#pragma unroll
    for (int d0 = 0; d0 < 8; ++d0) qr[d0] = *reinterpret_cast<const bf16x8*>(Qw + d0 * 16);
    const int vb0 = (int)(size_t)Vst + v_rd_base(lane);
#define ISSUEB(jt, ST) do { const int _j = (jt); const char* _k; const char* _v; unsigned _ld;                                   \
    if (_j < a.n0) { _ld = (unsigned)a.ld0 * 2u; const size_t _o = (size_t)_j * 64 * _ld; _k = (const char*)a.K0 + _o; _v = (const char*)a.V0 + _o; }                         \
    else { int _st = a.s1_start + (_j - a.n0) * 64; _st = max(0, min(_st, a.s1_max)); _ld = (unsigned)a.ld1 * 2u; const size_t _o = (size_t)_st * _ld; _k = (const char*)a.K1 + _o; _v = (const char*)a.V1 + _o; } \
    unsigned _ln = (unsigned)lane; asm volatile("" : "+v"(_ln));                                                                  \
    _Pragma("unroll") for (int _i = 0; _i < 2; ++_i) { const unsigned _s = (unsigned)((wid * 2 + _i) * 64) + _ln;                 \
        const unsigned _rk = _s >> 4, _ck = ((_s & 15u) << 4) ^ ((_rk & 7u) << 4);                                                \
        const unsigned _sub = _s >> 5, _w5 = _s & 31u, _kk = (_sub >> 2) * 8u + (_w5 >> 2);                                         \
        const unsigned _rv = (_kk & ~0xCu) | ((_kk & 4u) << 1) | ((_kk & 8u) >> 1), _cv = ((_sub & 3u) * 32u + (_w5 & 3u) * 8u) * 2u; \
        unsigned _ok = _rk * _ld + _ck, _ov = _rv * _ld + _cv; asm volatile("" : "+v"(_ok), "+v"(_ov));                           \
        __builtin_amdgcn_global_load_lds((const unsigned*)(_k + _ok), (LAS unsigned*)(Kst + (ST) * STG + (wid * 2 + _i) * 1024), 16, 0, 0); \
        __builtin_amdgcn_global_load_lds((const unsigned*)(_v + _ov), (LAS unsigned*)(Vst + (ST) * 2 * STG + (wid * 2 + _i) * 1024), 16, 0, 0); \
        __builtin_amdgcn_global_load_lds((const unsigned*)(_v + 256 + _ov), (LAS unsigned*)(Vst + (ST) * 2 * STG + STG + (wid * 2 + _i) * 1024), 16, 0, 0); } } while (0)
#define WAITV(n) asm volatile("s_waitcnt vmcnt(" #n ")" ::: "memory")
#define BAR() do { asm volatile("s_waitcnt lgkmcnt(0)" ::: "memory"); __builtin_amdgcn_s_barrier(); asm volatile("" ::: "memory"); SBAR(); } while (0)
    const int NT = a.n0 + a.n1;
    ISSUEB(0, 0);
    int st = 0;
#pragma unroll 1
    for (int j = 0; j < NT; ++j) {
        const int stn = (st == 2) ? 0 : st + 1;
        if (j + 1 < NT) { ISSUEB(j + 1, stn); WAITV(6); } else WAITV(0);
        BAR();
        f32x16 p0, p1; float mn, alpha; bf16x8 pa0, pa1, pa2, pa3;
        qkt(p0, p1, Kst + st * STG, qr, r32, hi); SBAR();
        partialSM(p0, p1, m_reg, mn, alpha);
        finishSM(p0, p1, alpha, l_reg, pa0, pa1, pa2, pa3); SBAR();
        if (__any(alpha < 1.f)) { if (hi == 0) al_l[r32] = alpha; asm volatile("s_waitcnt lgkmcnt(0)" ::: "memory");
#pragma unroll
            for (int d = 0; d < 8; ++d)
#pragma unroll
                for (int r = 0; r < 16; ++r) o[d][r] *= al_l[crow(r, hi)]; }
        SBAR();
        const int vb = vb0 + st * 2 * STG;
        pv_pipe<2>(o, vb, pa0, pa1, pa2, pa3);
        st = stn;
    }
    if (hi == 0) li_l[r32] = l_reg;
    BAR();
    {
        int wu = wid; unsigned ln = (unsigned)lane;
        asm volatile("" : "+s"(wu), "+v"(ln));
        char* Ow = (char*)(a.O + (size_t)(wu * 32) * a.ldo); const unsigned ldo2 = (unsigned)a.ldo * 2u;
        LAS unsigned char* img = lds + (unsigned)wu * 16384u;
        const unsigned wb = (ln >> 5) * 4u * 512u + (ln & 31u) * 2u;
#pragma unroll
        for (int r = 0; r < 16; ++r) { const float rli = __builtin_amdgcn_rcpf(li_l[crow(r, hi)]); const unsigned ro = wb + (unsigned)((r & 3) + 8 * (r >> 2)) * 512u;
#pragma unroll
            for (int d = 0; d < 8; ++d) *(LAS bf16_t*)(img + ro + d * 64) = (bf16_t)(cvtpk(o[d][r] * rli, 0.f) & 0xffffu); }
        asm volatile("s_waitcnt lgkmcnt(0)" ::: "memory");
        if (!a.fuse) {
#pragma unroll
            for (int i = 0; i < 16; ++i) { const unsigned c = (unsigned)i * 64u + ln; const unsigned row = c >> 5, ch = (c & 31u) * 16u;
                *(u32x4*)(Ow + row * ldo2 + ch) = *(const LAS u32x4*)(img + row * 512u + ch); }
        } else {
            const char* Gw = (const char*)(a.Gp + (size_t)(wu * 32) * a.ldg); const unsigned ldg2 = (unsigned)a.ldg * 2u;
            const float lam = a.lam; const unsigned cc = (ln & 31u) * 8u;
            const f32x4 sb0 = *(const f32x4*)(a.subln + cc), sb1 = *(const f32x4*)(a.subln + cc + 4);
#pragma unroll 1
            for (int i0 = 0; i0 < 16; i0 += 8) {
                u32x4 w1[8], wg[8];
#pragma unroll
                for (int u = 0; u < 8; ++u) { const unsigned c = (unsigned)(i0 + u) * 64u + ln; const unsigned row = c >> 5, ch = (c & 31u) * 16u;
                    w1[u] = *(const u32x4*)(Ow + row * ldo2 + ch); wg[u] = *(const u32x4*)(Gw + row * ldg2 + ch); }
#pragma unroll
                for (int u = 0; u < 8; ++u) { const unsigned c = (unsigned)(i0 + u) * 64u + ln; const unsigned row = c >> 5, ch = (c & 31u) * 16u;
                    const u32x4 w2 = *(const LAS u32x4*)(img + row * 512u + ch);
                    float d[8] = {bf_lo(w1[u].x) - lam * bf_lo(w2.x), bf_hi(w1[u].x) - lam * bf_hi(w2.x), bf_lo(w1[u].y) - lam * bf_lo(w2.y), bf_hi(w1[u].y) - lam * bf_hi(w2.y),
                                  bf_lo(w1[u].z) - lam * bf_lo(w2.z), bf_hi(w1[u].z) - lam * bf_hi(w2.z), bf_lo(w1[u].w) - lam * bf_lo(w2.w), bf_hi(w1[u].w) - lam * bf_hi(w2.w)};
                    const float g[8] = {bf_lo(wg[u].x), bf_hi(wg[u].x), bf_lo(wg[u].y), bf_hi(wg[u].y), bf_lo(wg[u].z), bf_hi(wg[u].z), bf_lo(wg[u].w), bf_hi(wg[u].w)};
                    float ss = 0;
#pragma unroll
                    for (int q = 0; q < 8; ++q) ss += d[q] * d[q];
                    ss += shx(ss, 16, (int)ln); ss += shx(ss, 8, (int)ln); ss += shx(ss, 4, (int)ln); ss += shx(ss, 2, (int)ln); ss += shx(ss, 1, (int)ln);
                    const float rs = rsqrtf(ss * (1.f / 256.f) + 1e-6f) * (1.f - LINIT);
#pragma unroll
                    for (int q = 0; q < 8; ++q) d[q] = d[q] * rs * (q < 4 ? sb0[q & 3] : sb1[q & 3]) * silu_f(g[q]);
                    u32x4 wo; wo.x = cvtpk(d[0], d[1]); wo.y = cvtpk(d[2], d[3]); wo.z = cvtpk(d[4], d[5]); wo.w = cvtpk(d[6], d[7]);
                    *(u32x4*)(Ow + row * ldo2 + ch) = wo; }
            }
        }
    }
    BAR();
#undef ISSUEB
#undef WAITV
#undef BAR
}

DI void cvt_array(const float* src, bf16_t* dst, long n, int bid, int G, int tid) {
    for (long i = ((long)bid * NTHREADS + tid) * 8; i < n; i += (long)G * NTHREADS * 8) {
        const f32x4 a = *(const f32x4*)(src + i), b = *(const f32x4*)(src + i + 4);
        u32x4 w; w.x = cvtpk(a[0], a[1]); w.y = cvtpk(a[2], a[3]); w.z = cvtpk(b[0], b[1]); w.w = cvtpk(b[2], b[3]);
        *(u32x4*)(dst + i) = w;
    }
}

DI void cvt_array_perm(const float* src, bf16_t* dst, long n, int bid, int G, int tid) {
    for (long i = ((long)bid * NTHREADS + tid) * 8; i < n; i += (long)G * NTHREADS * 8) {
        const long vb = i & ~127L; const int L = (int)(i & 127) >> 3, ax = L >> 3, f0 = (L & 7) * 4;
        const f32x4 a = *(const f32x4*)(src + vb + 64 * ax + f0), b = *(const f32x4*)(src + vb + 64 * ax + 32 + f0);
        u32x4 w; w.x = cvtpk(a[0], b[0]); w.y = cvtpk(a[1], b[1]); w.z = cvtpk(a[2], b[2]); w.w = cvtpk(a[3], b[3]);
        *(u32x4*)(dst + i) = w;
    }
}

DI void phase0(const Params& p, char* lds) {
    int tid_ = threadIdx.x; asm volatile("" : "+v"(tid_));
    const int tid = tid_, G = gridDim.x, bid = blockIdx.x;
    unsigned char* ws = p.ws;
    float* T = (float*)lds;
    for (int it = bid; it < 17408; it += G) {
        const int ct = it >> 5, kt = it & 31;
        const float* src; bf16_t* dst; int N, n0; int qklim = 0;
        if (ct < 160) { const int jj = ct / 80; N = 5120; qklim = 2560; n0 = (ct % 80) * 64; src = p.in[16] + (size_t)jj * 2048 * 5120; dst = (bf16_t*)(ws + WS_WTA) + (size_t)jj * 5120 * 2048; }
        else if (ct < 288) { N = 8192; qklim = 4096; n0 = (ct - 160) * 64; src = p.in[18]; dst = (bf16_t*)(ws + WS_WTB); }
        else if (ct < 416) { N = 8192; qklim = 4096; n0 = (ct - 288) * 64; src = p.in[21]; dst = (bf16_t*)(ws + WS_WTC); }
        else { const int jj = (ct - 416) >> 5; N = 2048; n0 = ((ct - 416) & 31) * 64; src = p.in[13] + (size_t)jj * 2048 * 2048; dst = (bf16_t*)(ws + WS_WTO) + (size_t)jj * 2048 * 2048; }
        const int k0 = kt * 64;
        __syncthreads();
#pragma unroll
        for (int i = 0; i < 2; ++i) { const int k = (tid >> 4) + 32 * i, n4 = (tid & 15) * 4;
            const f32x4 v = *(const f32x4*)(src + (size_t)(k0 + k) * N + n0 + n4);
            T[k * 65 + n4 + 0] = v[0]; T[k * 65 + n4 + 1] = v[1]; T[k * 65 + n4 + 2] = v[2]; T[k * 65 + n4 + 3] = v[3]; }
        __syncthreads();
        { const int n = tid >> 3, k8 = (tid & 7) * 8; u32x4 w;
          w.x = cvtpk(T[(k8 + 0) * 65 + n], T[(k8 + 1) * 65 + n]); w.y = cvtpk(T[(k8 + 2) * 65 + n], T[(k8 + 3) * 65 + n]);
          w.z = cvtpk(T[(k8 + 4) * 65 + n], T[(k8 + 5) * 65 + n]); w.w = cvtpk(T[(k8 + 6) * 65 + n], T[(k8 + 7) * 65 + n]);
          int nn = n0 + n; if (nn < qklim) nn = (nn & ~127) + hd_phys(nn & 127);
          *(u32x4*)(dst + (size_t)nn * 2048 + k0 + k8) = w; }
    }
    bf16_t* cb = (bf16_t*)(ws + WS_CACHE);
    cvt_array_perm(p.in[2], cb + C_AK, 2097152, bid, G, tid); cvt_array(p.in[3], cb + C_AV, 2097152, bid, G, tid);
    cvt_array_perm(p.in[4], cb + C_BK, 4194304, bid, G, tid); cvt_array(p.in[5], cb + C_BV, 4194304, bid, G, tid);
    cvt_array_perm(p.in[6], cb + C_CK, 4194304, bid, G, tid); cvt_array(p.in[7], cb + C_CV, 4194304, bid, G, tid);
    float* scl = (float*)lds + 8192;
    float* part = (float*)(ws + WS_PART);
    for (int it = bid; it < 768; it += G) {
        const int l = it / 192, rem = it % 192, cc = rem >> 4, kc = rem & 15;
        __syncthreads();
        for (int e = tid; e < 9 * 128; e += NTHREADS) { const int r = e >> 7, k = e & 127;
            const float cv = (r == 0) ? p.in[9][kc * 128 + k] : p.in[8][(r - 1) * 2048 + kc * 128 + k]; scl[e] = silu_f(cv); }
        __syncthreads();
        const float* W = p.in[11] + ((size_t)l * 2048 + kc * 128) * 6144 + cc * 512 + tid;
        float a0 = 0, a1 = 0, a2 = 0, a3 = 0, a4 = 0, a5 = 0, a6 = 0, a7 = 0, a8 = 0;
#pragma unroll 8
        for (int k = 0; k < 128; ++k) { const float w = W[(size_t)k * 6144];
            a0 += scl[k] * w; a1 += scl[128 + k] * w; a2 += scl[256 + k] * w; a3 += scl[384 + k] * w; a4 += scl[512 + k] * w;
            a5 += scl[640 + k] * w; a6 += scl[768 + k] * w; a7 += scl[896 + k] * w; a8 += scl[1024 + k] * w; }
        float* po = part + ((size_t)(l * 16 + kc) * 9) * 6144 + cc * 512 + tid;
        po[0] = a0; po[6144] = a1; po[2 * 6144] = a2; po[3 * 6144] = a3; po[4 * 6144] = a4; po[5 * 6144] = a5; po[6 * 6144] = a6; po[7 * 6144] = a7; po[8 * 6144] = a8;
    }
    if (bid == G - 1) {
        float* ct = (float*)(ws + WS_ROPE); float* st = ct + 2048;
        for (int e = tid; e < 2048; e += NTHREADS) { const int pos = e >> 5, f = e & 31;
            double inv = 1.0; for (int q = 0; q < f; ++q) inv *= 0.74989420933245582730;
            const float invf = (float)inv; const float angf = (float)pos * invf;
            double x = (double)angf; const double twopi = 6.283185307179586476925;
            const double kq = __builtin_rint(x / twopi); x -= kq * twopi;
            const double x2 = x * x; double sn = x, cs = 1.0, ts = x, tc = 1.0;
            for (int q = 1; q <= 12; ++q) { tc *= -x2 / (double)((2 * q - 1) * (2 * q)); cs += tc; ts *= -x2 / (double)((2 * q) * (2 * q + 1)); sn += ts; }
            ct[e] = (float)cs; st[e] = (float)sn; }
    }
}

DI void ada_reduce(const Params& p) {
    int tid_ = threadIdx.x; asm volatile("" : "+v"(tid_));
    const int tid = tid_, G = gridDim.x, bid = blockIdx.x;
    unsigned char* ws = p.ws;
    const float* part = (const float*)(ws + WS_PART);
    float* modA = (float*)(ws + WS_MODA); float* modB = (float*)(ws + WS_MODB); float* gate = (float*)(ws + WS_GATE);
    for (int e = bid * NTHREADS + tid; e < 4 * 9 * 6144; e += G * NTHREADS) {
        const int j = e % 6144, lr = e / 6144, l = lr / 9, r = lr % 9;
        float m = p.in[12][l * 6144 + j];
#pragma unroll
        for (int kc = 0; kc < 16; ++kc) m += part[((size_t)(l * 16 + kc) * 9 + r) * 6144 + j];
        if (j < 2048) modB[lr * 2048 + j] = m;
        else if (j < 4096) modA[lr * 2048 + j - 2048] = p.in[10][l * 2048 + j - 2048] * (1.f + m);
        else gate[lr * 2048 + j - 4096] = m;
    }
    if (bid == 0 && tid < 64) {
        const float* lam = p.in[19]; float s1 = 0, s2 = 0;
        for (int k = tid; k < 128; k += 64) { s1 += lam[k] * lam[128 + k]; s2 += lam[256 + k] * lam[384 + k]; }
#pragma unroll
        for (int o = 32; o >= 1; o >>= 1) { s1 += shx(s1, o, tid); s2 += shx(s2, o, tid); }
        if (tid == 0) ((float*)(ws + WS_MISC))[0] = expf(s1) - expf(s2) + LINIT;
    }
}

DI void prenorm(const Params& p, int l) {
    int tid_ = threadIdx.x; asm volatile("" : "+v"(tid_));
    const int tid = tid_, G = gridDim.x, bid = blockIdx.x, wid = tid >> 6, lane = tid & 63;
    unsigned char* ws = p.ws; bf16_t* H = (bf16_t*)(ws + WS_H);
    f32x4 v[8], vn[8];
    int t = bid * 8 + wid;
#define PN_SRC(tt) ((l == 0) ? ((tt) < M_CTX ? p.in[0] + (size_t)(tt) * DM : p.in[1] + (size_t)((tt) - M_CTX) * DM) : p.out + (size_t)(tt) * DM)
    if (t < MT) { const float* x = PN_SRC(t);
#pragma unroll
        for (int i = 0; i < 8; ++i) v[i] = *(const f32x4*)(x + i * 256 + lane * 4); }
    for (; t < MT; t += G * 8) {
        const int tn = t + G * 8;
        if (tn < MT) { const float* xn = PN_SRC(tn);
#pragma unroll
            for (int i = 0; i < 8; ++i) vn[i] = *(const f32x4*)(xn + i * 256 + lane * 4); }
        const int r9 = t < M_CTX ? 0 : 1 + ((t - M_CTX) >> 12);
        const float* A = (const float*)(ws + WS_MODA) + (l * 9 + r9) * DM; const float* B = (const float*)(ws + WS_MODB) + (l * 9 + r9) * DM;
        f32x4 am[8], bm[8];
#pragma unroll
        for (int i = 0; i < 8; ++i) { am[i] = *(const f32x4*)(A + i * 256 + lane * 4); bm[i] = *(const f32x4*)(B + i * 256 + lane * 4); }
        float ss = 0;
#pragma unroll
        for (int i = 0; i < 8; ++i) ss += v[i][0] * v[i][0] + v[i][1] * v[i][1] + v[i][2] * v[i][2] + v[i][3] * v[i][3];
#pragma unroll
        for (int o = 32; o >= 1; o >>= 1) ss += shx(ss, o, lane);
        const float rs = rsqrtf(ss * (1.f / 2048.f) + 1e-6f);
#pragma unroll
        for (int i = 0; i < 8; ++i) { const f32x4 y = v[i] * rs * am[i] + bm[i]; u32x2 w; w.x = cvtpk(y[0], y[1]); w.y = cvtpk(y[2], y[3]);
            *(u32x2*)(H + (size_t)t * DM + i * 256 + lane * 4) = w; }
#pragma unroll
        for (int i = 0; i < 8; ++i) v[i] = vn[i];
    }
#undef PN_SRC
}

DI void bpost(const Params& p) {
    int tid_ = threadIdx.x; asm volatile("" : "+v"(tid_));
    const int tid = tid_, G = gridDim.x, bid = blockIdx.x, i = tid & 31, ln = tid & 63;
    unsigned char* ws = p.ws; bf16_t* QK = (bf16_t*)(ws + WS_QKVG); bf16_t* OG = (bf16_t*)(ws + WS_H);
    const float lam = ((const float*)(ws + WS_MISC))[0];
    const f32x4 sb0 = *(const f32x4*)(p.in[20] + i * 8), sb1 = *(const f32x4*)(p.in[20] + i * 8 + 4);
    const int tstep = G * (NTHREADS / 32);
    u32x4 w1[4], w2[4], wg[4], n1[4], n2[4], ng[4];
#define BP_LD(A1, A2, AG, tt, hh0) do { _Pragma("unroll") for (int u = 0; u < 4; ++u) { const int _h = (hh0) + u;                   \
        A1[u] = *(const u32x4*)(OG + (size_t)(tt) * 2048 + _h * 256 + i * 8); A2[u] = *(const u32x4*)(QK + (size_t)(tt) * 8192 + _h * 256 + i * 8); \
        AG[u] = *(const u32x4*)(QK + (size_t)(tt) * 8192 + 6144 + _h * 256 + i * 8); } } while (0)
    int t = (bid * NTHREADS + tid) >> 5;
    if (t < MT) BP_LD(w1, w2, wg, t, 0);
    for (; t < MT; t += tstep) {
#pragma unroll 1
        for (int h0 = 0; h0 < 8; h0 += 4) {
            const int tn = (h0 == 0) ? t : t + tstep, hn = (h0 == 0) ? 4 : 0;
            if (tn < MT) BP_LD(n1, n2, ng, tn, hn);
#pragma unroll
            for (int u = 0; u < 4; ++u) { const int h = h0 + u;
                float d[8] = {bf_lo(w1[u].x) - lam * bf_lo(w2[u].x), bf_hi(w1[u].x) - lam * bf_hi(w2[u].x), bf_lo(w1[u].y) - lam * bf_lo(w2[u].y), bf_hi(w1[u].y) - lam * bf_hi(w2[u].y),
                              bf_lo(w1[u].z) - lam * bf_lo(w2[u].z), bf_hi(w1[u].z) - lam * bf_hi(w2[u].z), bf_lo(w1[u].w) - lam * bf_lo(w2[u].w), bf_hi(w1[u].w) - lam * bf_hi(w2[u].w)};
                const float g[8] = {bf_lo(wg[u].x), bf_hi(wg[u].x), bf_lo(wg[u].y), bf_hi(wg[u].y), bf_lo(wg[u].z), bf_hi(wg[u].z), bf_lo(wg[u].w), bf_hi(wg[u].w)};
                float ss = 0;
#pragma unroll
                for (int q = 0; q < 8; ++q) ss += d[q] * d[q];
                ss += shx(ss, 16, ln); ss += shx(ss, 8, ln); ss += shx(ss, 4, ln); ss += shx(ss, 2, ln); ss += shx(ss, 1, ln);
                const float rs = rsqrtf(ss * (1.f / 256.f) + 1e-6f) * (1.f - LINIT);
#pragma unroll
                for (int q = 0; q < 8; ++q) d[q] = d[q] * rs * (q < 4 ? sb0[q & 3] : sb1[q & 3]) * silu_f(g[q]);
                u32x4 wo; wo.x = cvtpk(d[0], d[1]); wo.y = cvtpk(d[2], d[3]); wo.z = cvtpk(d[4], d[5]); wo.w = cvtpk(d[6], d[7]);
                *(u32x4*)(OG + (size_t)t * 2048 + h * 256 + i * 8) = wo; }
#pragma unroll
            for (int u = 0; u < 4; ++u) { w1[u] = n1[u]; w2[u] = n2[u]; wg[u] = ng[u]; }
        }
    }
#undef BP_LD
}

DI void attn_phase(const Params& p, int kind, int jdx, LAS unsigned char* lds) {
    int tid_ = threadIdx.x; asm volatile("" : "+v"(tid_));
    const int G = gridDim.x, bid = blockIdx.x, tid = tid_;
    unsigned char* ws = p.ws; bf16_t* QK = (bf16_t*)(ws + WS_QKVG); bf16_t* OG = (bf16_t*)(ws + WS_H); const bf16_t* cb = (const bf16_t*)(ws + WS_CACHE);
    LAS float* rpbL = (LAS float*)(lds + RPB_OFF);
    const int nlat = (kind == 1) ? 1024 : 2048, nitems = (kind == 1) ? 1280 : 2560, npass = (kind == 1) ? 2 : 1;
    const long N = (kind == 0) ? 5120 : 8192;
#pragma unroll 1
    for (int it = bid; it < nitems; it += G) {
#pragma unroll 1
        for (int ps = 0; ps < npass; ++ps) {
            AttnArgs a; a.fuse = 0; a.subln = nullptr; a.lam = 0.f; a.ldq = N; a.ldg = N; a.ldo = 2048; a.has_sink = 0; a.sinkl2 = 0.f; a.out_mode = 0; a.r0 = 0; a.rbase = 0; a.mode = 0; a.qpos0 = 0; a.s1_start = 0; a.s1_max = 4032; a.n0 = 4; a.ld1 = N;
            __syncthreads();
            const bool lat = it < nlat;
            if (kind == 0) {
                int b, h; long row0;
                if (lat) { b = it >> 8; const int rem = it & 255, qb = rem >> 4; h = (rem & 3) * 4 + ((rem >> 2) & 1) * 2 + ((rem >> 3) & 1); row0 = M_CTX + b * 4096 + qb * 256;
                    a.K0 = cb + C_AK + ((size_t)(b * 2 + jdx) * 256) * 512 + (h >> 2) * 128; a.V0 = a.K0 + (C_AV - C_AK); a.ld0 = 512;
                    a.K1 = QK + (long)(M_CTX + b * 4096) * N + 2048 + (h >> 2) * 128; a.n1 = 8; a.s1_start = qb * 256 - 128; a.mode = 1; a.qpos0 = qb * 256; }
                else { const int id = it - 2048; b = id >> 4; h = (id & 3) * 4 + ((id >> 2) & 1) * 2 + ((id >> 3) & 1); row0 = b * 256;
                    a.K0 = QK + row0 * N + 2048 + (h >> 2) * 128; a.V0 = a.K0 + 512; a.ld0 = N; a.K1 = a.K0; a.n1 = 0; }
                a.V1 = a.K1 + 512; a.has_sink = 1; a.sinkl2 = p.in[17][jdx * 16 + h] * LOG2E;
                a.Q = QK + row0 * N + h * 128; a.O = OG + row0 * 2048 + h * 128; a.Gp = QK + row0 * N + 3072 + h * 128;
            } else if (kind == 1) {
                const int m = ps; int b, h; long row0, krow0;
                if (lat) { b = it >> 7; const int rem = it & 127, qb = rem >> 3; h = rem & 7; row0 = M_CTX + b * 4096 + qb * 256; krow0 = M_CTX + b * 4096; a.n1 = 64;
                    a.K0 = cb + C_BK + (size_t)b * 256 * 2048 + h * 256 + m * 128; a.V0 = cb + C_BV + (size_t)b * 256 * 2048 + h * 256; a.ld0 = 2048; }
                else { const int id = it - 1024; b = id >> 3; h = id & 7; row0 = b * 256; krow0 = row0; a.n1 = 0;
                    a.K0 = QK + row0 * N + 2048 + h * 256 + m * 128; a.V0 = QK + row0 * N + 4096 + h * 256; a.ld0 = N; }
                a.Q = QK + row0 * N + h * 256 + m * 128;
                a.K1 = QK + krow0 * N + 2048 + h * 256 + m * 128; a.V1 = QK + krow0 * N + 4096 + h * 256;
                a.out_mode = 1; a.Gp = QK + row0 * N + 6144 + h * 256; a.O = OG + row0 * 2048 + h * 256;
                a.fuse = m; a.subln = p.in[20]; a.lam = ((const float*)(ws + WS_MISC))[0];
                attn_body_b(a, lds);
                continue;
            } else {
                int b, h; long row0;
                if (lat) { b = it >> 8; const int rem = it & 255, qb = rem >> 4; h = rem & 15; row0 = M_CTX + b * 4096 + qb * 256;
                    for (int e = tid; e < 465; e += NTHREADS) rpbL[e] = p.in[22][h * 465 + e] * (1.f / SCALE);
                    a.K0 = cb + C_CK + (size_t)b * 256 * 2048 + h * 128; a.V0 = a.K0 + (C_CV - C_CK); a.ld0 = 2048;
                    a.K1 = QK + (long)(M_CTX + b * 4096) * N + 2048 + h * 128; a.n1 = 12;
                    a.r0 = qb * 4; a.rbase = min(max(qb * 4 - 4, 0), 52); a.s1_start = a.rbase * 64; a.mode = 2; }
                else { const int id = it - 2048; b = id >> 4; h = id & 15; row0 = b * 256;
                    a.K0 = QK + row0 * N + 2048 + h * 128; a.V0 = a.K0 + 2048; a.ld0 = N; a.K1 = a.K0; a.n1 = 0; }
                a.V1 = a.K1 + 2048;
                a.Q = QK + row0 * N + h * 128; a.O = OG + row0 * 2048 + h * 128; a.Gp = QK + row0 * N + 6144 + h * 128;
            }
            attn_body(a, lds);
        }
    }
}

#define XB_TMO      128
#define XB_XCNT(j)  (256  + 64 * (j))
#define XB_XSUB(j)  (1280 + 64 * (j))
#define XB_XGEN(j)  (2304 + 64 * (j))
#define XB_TOP      3328
#define XB_TOPGEN   3392
#define XCD_BAR_WORDS 3456
#define XB_SPIN_CAP (1u << 18)
DI unsigned xb_ld(unsigned* p)              { return __hip_atomic_load(p, __ATOMIC_RELAXED, __HIP_MEMORY_SCOPE_AGENT); }
DI unsigned xb_add(unsigned* p, unsigned v) { return __hip_atomic_fetch_add(p, v, __ATOMIC_RELAXED, __HIP_MEMORY_SCOPE_AGENT); }
DI unsigned xb_xcc_id() { return (unsigned)__builtin_amdgcn_s_getreg((3 << 11) | 20) & 0xFu; }
#define XB_SPIN(cond, bar) do { unsigned _sp = 0; while (cond) { __builtin_amdgcn_s_sleep(1); \
    if ((++_sp & 255u) == 0u) { if (xb_ld(&(bar)[XB_TMO])) break; if (_sp > XB_SPIN_CAP) { atomicAdd(&(bar)[XB_TMO], 1u); break; } } } } while (0)
DI void xcd_barrier_complete(unsigned* bar, unsigned x, unsigned& nloc, unsigned& nx) {
    const unsigned G = gridDim.x;
    unsigned sum, cnt, mine, sp = 0u;
    for (;;) {
        sum = 0u; cnt = 0u; mine = 0u;
#pragma unroll
        for (unsigned j = 0; j < 16; ++j) { const unsigned c = xb_ld(&bar[XB_XCNT(j)]); sum += c; cnt += (c > 0u) ? 1u : 0u; mine = (j == x) ? c : mine; }
        if (sum == G) break;
        __builtin_amdgcn_s_sleep(1);
        if ((++sp & 255u) == 0u) { if (xb_ld(&bar[XB_TMO])) break; if (sp > XB_SPIN_CAP) { atomicAdd(&bar[XB_TMO], 1u); break; } }
    }
    nloc = mine > 0u ? mine : 1u; nx = cnt > 0u ? cnt : 1u;
}
DI void xcd_barrier(unsigned* bar, volatile LAS unsigned* st) {
    asm volatile("s_waitcnt vmcnt(0)" ::: "memory");
    __syncthreads();
    if (threadIdx.x == 0) {
        const unsigned x = xb_xcc_id();
        __builtin_amdgcn_s_waitcnt(0);
        unsigned nloc = st[0], nx = st[1];
        if (nloc == 0u) { xcd_barrier_complete(bar, x, nloc, nx); st[0] = nloc; st[1] = nx; }
        const unsigned old = xb_add(&bar[XB_XSUB(x)], 1u);
        const unsigned gen = old / nloc;
        if (old + 1u == (gen + 1u) * nloc) {
            __builtin_amdgcn_fence(__ATOMIC_RELEASE, "agent");
            asm volatile("s_waitcnt vmcnt(0)" ::: "memory");
            const unsigned og = xb_add(&bar[XB_TOP], 1u);
            const unsigned tg = og / nx;
            if (og + 1u == (tg + 1u) * nx) xb_add(&bar[XB_TOPGEN], 1u);
            else XB_SPIN(xb_ld(&bar[XB_TOPGEN]) == tg, bar);
            __builtin_amdgcn_fence(__ATOMIC_ACQUIRE, "agent");
            xb_add(&bar[XB_XGEN(x)], 1u);
            asm volatile("s_waitcnt vmcnt(0)" ::: "memory");
        } else {
            XB_SPIN(xb_ld(&bar[XB_XGEN(x)]) == gen, bar);
            __builtin_amdgcn_fence(__ATOMIC_ACQUIRE, "agent");
            asm volatile("s_waitcnt vmcnt(0)" ::: "memory");
        }
    }
    __syncthreads();
}

__global__ void __launch_bounds__(NTHREADS, 2) fwd_megakernel(Params p) {
    extern __shared__ __attribute__((aligned(16))) unsigned char shm[];
    cg::grid_group grid = cg::this_grid();
    unsigned char* ws = p.ws;
    const int G = gridDim.x;
    volatile LAS unsigned* xst = (volatile LAS unsigned*)((LAS unsigned char*)shm + XB_ST_OFF);
    unsigned* xbar = (unsigned*)(ws + WS_BAR);
    if (threadIdx.x < 2) xst[threadIdx.x] = 0u;
    __syncthreads();
    if (threadIdx.x == 0) (void)xb_add(&xbar[XB_XCNT(xb_xcc_id())], 1u);
    phase0(p, (char*)shm);
    grid.sync();
    ada_reduce(p);
    xcd_barrier(xbar, xst);
#pragma unroll 1
    for (int l = 0; l < 4; ++l) {
        const int kind = l % 3, jdx = l / 3;
        prenorm(p, l);
        xcd_barrier(xbar, xst);
        {
            const bf16_t* Wt = (kind == 0) ? (const bf16_t*)(ws + WS_WTA) + (size_t)jdx * 5120 * 2048 : (kind == 1) ? (const bf16_t*)(ws + WS_WTB) : (const bf16_t*)(ws + WS_WTC);
            const int N = (kind == 0) ? 5120 : 8192;
            pg8::Gemm g{(const bf16_t*)(ws + WS_H), Wt, MT, N, DM}; pg8::StaticOrder S; S.init(MT, N, G, (int)blockIdx.x);
            pg8::EpiQKVG E{(bf16_t*)(ws + WS_QKVG), N, (kind == 0) ? 10 : 16, (kind == 0) ? 10 : 16, (kind == 0) ? 12 : 24, p.in[14] + l * 128, p.in[15] + l * 128,
                           (const float*)(ws + WS_ROPE), (kind != 2) ? 1 : 0, p.out + (kind == 0 ? O_AK : kind == 1 ? O_BK : O_CK), p.out + (kind == 0 ? O_AV : kind == 1 ? O_BV : O_CV), (kind == 0) ? 1 : 0, jdx};
            pg8::gemm_phase<pg8::EpiQKVG, pg8::StaticOrder>((LAS unsigned char*)shm, g, S, E);
        }
        xcd_barrier(xbar, xst);
        attn_phase(p, kind, jdx, (LAS unsigned char*)shm);
        xcd_barrier(xbar, xst);
        {
            pg8::Gemm g{(const bf16_t*)(ws + WS_H), (const bf16_t*)(ws + WS_WTO) + (size_t)l * 2048 * 2048, MT, DM, DM}; pg8::StaticOrder S; S.init(MT, DM, G, (int)blockIdx.x);
            pg8::EpiOut E{l == 0 ? p.in[0] : p.out, l == 0 ? p.in[1] : p.out + (size_t)M_CTX * DM, p.out, (const float*)(ws + WS_GATE) + (size_t)l * 9 * DM};
            pg8::gemm_phase<pg8::EpiOut, pg8::StaticOrder>((LAS unsigned char*)shm, g, S, E);
        }
        if (l < 3) xcd_barrier(xbar, xst);
    }
}

extern "C" void kernel_launch(void* const* d_in, const int* in_sizes, int n_in, void* d_out, int out_size, void* d_ws, size_t ws_size, hipStream_t stream) {
    static int grid_blocks = 0;
    if (grid_blocks == 0) {
        if (n_in != 23 || ws_size < WS_END) { fprintf(stderr, "kernel_launch: unexpected n_in %d or ws_size %zu (need %zu)\n", n_in, ws_size, (size_t)WS_END); grid_blocks = -1; return; }
        int dev = 0, cus = 0, per_cu = 0;
        hipGetDevice(&dev);
        hipDeviceGetAttribute(&cus, hipDeviceAttributeMultiprocessorCount, dev);
        if (hipFuncSetAttribute((const void*)fwd_megakernel, hipFuncAttributeMaxDynamicSharedMemorySize, LDS_BYTES) != hipSuccess) { fprintf(stderr, "kernel_launch: hipFuncSetAttribute failed\n"); grid_blocks = -1; return; }
        hipOccupancyMaxActiveBlocksPerMultiprocessor(&per_cu, (const void*)fwd_megakernel, NTHREADS, LDS_BYTES);
        if (per_cu < 1) { fprintf(stderr, "kernel_launch: occupancy query says %d blocks per CU\n", per_cu); per_cu = 1; }
        (void)hipGetLastError();
        grid_blocks = cus * 1;
    }
    if (grid_blocks < 0) return;
    if (hipMemsetAsync((char*)d_ws + WS_BAR, 0, XCD_BAR_WORDS * 4, stream) != hipSuccess) { fprintf(stderr, "kernel_launch: hipMemsetAsync of the barrier words failed\n"); return; }
    Params p{};
    for (int i = 0; i < 23; ++i) p.in[i] = (const float*)d_in[i];
    p.out = (float*)d_out; p.ws = (unsigned char*)d_ws;
    void* args[] = {&p};
    hipError_t e = hipLaunchCooperativeKernel((const void*)fwd_megakernel, dim3(grid_blocks), dim3(NTHREADS), args, LDS_BYTES, stream);
    if (e != hipSuccess) fprintf(stderr, "cooperative launch failed: %s (grid %d)\n", hipGetErrorString(e), grid_blocks);
}
```
